# Optimizing an MI355X kernel written in HIP

```python
import jax, jax.numpy as jnp
from jax import lax
import numpy as np

D_MODEL = 2048
BATCH = 1
SEQ = 16384
DEPTH = 2

EPS = 1e-6
NEG_INF = -1e30

HEAD_DIM_A = 64
N_Q_HEADS_A = (D_MODEL // 2) // HEAD_DIM_A
N_KV_HEADS_A = N_Q_HEADS_A // 8
Q_PER_KV_A = N_Q_HEADS_A // N_KV_HEADS_A
WIDTH_A = N_Q_HEADS_A * HEAD_DIM_A
KV_WIDTH_A = N_KV_HEADS_A * HEAD_DIM_A
WINDOW = 128

CHUNK_B = 128
WIDTH_B = D_MODEL // 2
N_GROUPS_B = 8
GROUP_B = WIDTH_B // N_GROUPS_B

HEAD_K_C = 128
HEAD_V_C = 128
WIDTH_C = D_MODEL // 2
N_HEADS_C = WIDTH_C // HEAD_V_C
KEY_WIDTH_C = N_HEADS_C * HEAD_K_C

WIDTH_D = D_MODEL // 2
N_HEADS_D = 4
KEY_WIDTH_D = WIDTH_D // 2
HEAD_K_D = KEY_WIDTH_D // N_HEADS_D
HEAD_V_D = WIDTH_D // N_HEADS_D
GATE_RANK_D = 16
GATE_LOGIT_NORM_D = 16.0

LA_CHUNK = 64
PLE_DIM = 256

N_EVEN = (DEPTH + 1) // 2
N_ODD = DEPTH // 2

EVEN_SPLITS = (WIDTH_A, KV_WIDTH_A, KV_WIDTH_A, WIDTH_A, WIDTH_B, WIDTH_B, WIDTH_B)
ODD_SPLITS = (KEY_WIDTH_C, KEY_WIDTH_C, WIDTH_C, WIDTH_C,
              KEY_WIDTH_D, KEY_WIDTH_D, WIDTH_D, GATE_RANK_D, WIDTH_D)
IN_EVEN = sum(EVEN_SPLITS)
IN_ODD = sum(ODD_SPLITS)
MIX_EVEN = WIDTH_A + WIDTH_B
MIX_ODD = WIDTH_C + WIDTH_D

kernel_name = 'hybrid_swa_gmlp_hgrn2_gla_block'


def rmsnorm(x, g):
    xf = x.astype(jnp.float32)
    y = xf * lax.rsqrt(jnp.mean(xf * xf, axis=-1, keepdims=True) + EPS)
    return (y * g.astype(jnp.float32)).astype(x.dtype)


def head_rmsnorm(o, g, n_heads):
    b, s, w = o.shape
    of = o.astype(jnp.float32).reshape(b, s, n_heads, w // n_heads)
    of = of * lax.rsqrt(jnp.mean(of * of, axis=-1, keepdims=True) + EPS)
    return (of.reshape(b, s, w) * g.astype(jnp.float32)).astype(o.dtype)


def split_cols(z, sizes):
    offs = []
    acc = 0
    for sz in sizes[:-1]:
        acc += sz
        offs.append(acc)
    return jnp.split(z, offs, axis=-1)


def sliding_window_sink_attention(q, k, v, sinks):
    b, s, _, _ = q.shape
    n = s // WINDOW
    qb = q.reshape(b, n, WINDOW, N_KV_HEADS_A, Q_PER_KV_A, HEAD_DIM_A)
    kb = k.reshape(b, n, WINDOW, N_KV_HEADS_A, HEAD_DIM_A)
    vb = v.reshape(b, n, WINDOW, N_KV_HEADS_A, HEAD_DIM_A)
    prev = lambda t: jnp.concatenate([jnp.zeros_like(t[:, :1]), t[:, :-1]], axis=1)
    kk = jnp.concatenate([prev(kb), kb], axis=2)
    vv = jnp.concatenate([prev(vb), vb], axis=2)
    scores = jnp.einsum('bnqhgd,bnkhd->bnhgqk', qb, kk).astype(jnp.float32) * (HEAD_DIM_A ** -0.5)
    qi = jnp.arange(WINDOW)[:, None]
    kj = jnp.arange(2 * WINDOW)[None, :]
    band = (kj > qi) & (kj <= qi + WINDOW)
    valid = (jnp.arange(n)[:, None, None] > 0) | (kj >= WINDOW)[None]
    mask = band[None] & valid
    scores = jnp.where(mask[None, :, None, None], scores, NEG_INF)
    sink = jnp.broadcast_to(
        sinks.astype(jnp.float32).reshape(1, 1, N_KV_HEADS_A, Q_PER_KV_A, 1, 1),
        scores.shape[:-1] + (1,))
    probs = jax.nn.softmax(jnp.concatenate([scores, sink], axis=-1), axis=-1)[..., :-1]
    out = jnp.einsum('bnhgqk,bnkhd->bnqhgd', probs.astype(v.dtype), vv)
    return out.reshape(b, s, WIDTH_A)


def chunked_spatial_gating(u, v, w_s, b_s):
    b, s, _ = u.shape
    n = s // CHUNK_B
    vb = v.reshape(b, n, CHUNK_B, N_GROUPS_B, GROUP_B)
    causal = jnp.tril(jnp.ones((CHUNK_B, CHUNK_B), dtype=bool))
    w = jnp.where(causal[None], w_s, jnp.zeros_like(w_s))
    mixed = jnp.einsum('gts,bnsgc->bntgc', w, vb) + b_s.T[None, None, :, :, None]
    return u * mixed.reshape(b, s, WIDTH_B)


def chunked_gated_linear_attention(q, k, v, log_g, scale):
    b, s, h, dk = q.shape
    dv = v.shape[-1]
    n = s // LA_CHUNK
    to_chunks = lambda t: jnp.moveaxis(t.reshape(b, n, LA_CHUNK, h, t.shape[-1]), 1, 0)
    qc, kc, vc, gc = to_chunks(q * scale), to_chunks(k), to_chunks(v), to_chunks(log_g)
    causal = jnp.tril(jnp.ones((LA_CHUNK, LA_CHUNK), dtype=bool))[None, :, :, None, None]

    def step(state, inp):
        qi, ki, vi, gi = inp
        qf, kf, vf = qi.astype(jnp.float32), ki.astype(jnp.float32), vi.astype(jnp.float32)
        gcum = jnp.cumsum(gi.astype(jnp.float32), axis=1)
        o_inter = jnp.einsum('bthk,bhkv->bthv', qf * jnp.exp(gcum), state)
        diff = gcum[:, :, None] - gcum[:, None, :]
        decay = jnp.where(causal, jnp.exp(jnp.where(causal, diff, 0.0)), 0.0)
        attn = jnp.einsum('bthk,btshk->bhts', qf, decay * kf[:, None])
        o_intra = jnp.einsum('bhts,bshv->bthv', attn, vf)
        g_last = gcum[:, -1]
        k_dec = kf * jnp.exp(g_last[:, None] - gcum)
        new_state = state * jnp.exp(g_last)[..., None] + jnp.einsum('bshk,bshv->bhkv', k_dec, vf)
        return new_state, (o_inter + o_intra).astype(v.dtype)

    state0 = jnp.zeros((b, h, dk, dv), jnp.float32)
    _, out = lax.scan(step, state0, (qc, kc, vc, gc))
    return jnp.moveaxis(out, 0, 1).reshape(b, s, h * dv)


def even_mixer(hn, w_in, sinks, vnorm, w_sp, b_sp, w_out):
    b, s, _ = hn.shape
    z = hn @ w_in
    q, k, v, gate_a, u_b, v_b, gate_b = split_cols(z, EVEN_SPLITS)
    attn = sliding_window_sink_attention(
        q.reshape(b, s, N_Q_HEADS_A, HEAD_DIM_A),
        k.reshape(b, s, N_KV_HEADS_A, HEAD_DIM_A),
        v.reshape(b, s, N_KV_HEADS_A, HEAD_DIM_A), sinks)
    u_b = jax.nn.gelu(u_b, approximate=False)
    v_b = rmsnorm(jax.nn.gelu(v_b, approximate=False), vnorm)
    sgu = chunked_spatial_gating(u_b, v_b, w_sp, b_sp)
    y = jnp.concatenate([attn * jax.nn.silu(gate_a), sgu * jax.nn.silu(gate_b)], axis=-1)
    return y @ w_out


def odd_mixer(hn, layer, w_in, lower_bounds, onorm_c, w_gate_up_d, b_gate_d, onorm_d, w_out):
    b, s, _ = hn.shape
    z = hn @ w_in
    q_c, f_c, i_c, gate_c, q_d, k_d, v_d, glr_d, gate_d = split_cols(z, ODD_SPLITS)
    sm = jax.nn.softmax(lower_bounds.astype(jnp.float32), axis=0)
    lb = (jnp.cumsum(sm, axis=0) - sm[0])[layer].reshape(N_HEADS_C, HEAD_K_C)
    f = lb + (1.0 - lb) * jax.nn.sigmoid(f_c.astype(jnp.float32).reshape(b, s, N_HEADS_C, HEAD_K_C))
    o_c = chunked_gated_linear_attention(
        q_c.reshape(b, s, N_HEADS_C, HEAD_K_C), (1.0 - f).astype(hn.dtype),
        i_c.reshape(b, s, N_HEADS_C, HEAD_V_C), jnp.log(f), HEAD_K_C ** -0.5)
    o_c = head_rmsnorm(o_c, onorm_c, N_HEADS_C) * jax.nn.silu(gate_c)
    log_alpha = jax.nn.log_sigmoid((glr_d @ w_gate_up_d + b_gate_d).astype(jnp.float32)) / GATE_LOGIT_NORM_D
    o_d = chunked_gated_linear_attention(
        q_d.reshape(b, s, N_HEADS_D, HEAD_K_D), k_d.reshape(b, s, N_HEADS_D, HEAD_K_D),
        v_d.reshape(b, s, N_HEADS_D, HEAD_V_D), log_alpha.reshape(b, s, N_HEADS_D, HEAD_K_D),
        HEAD_K_D ** -0.5)
    o_d = head_rmsnorm(o_d, onorm_d, N_HEADS_D) * jax.nn.silu(gate_d)
    return jnp.concatenate([o_c, o_d], axis=-1) @ w_out


def setup_inputs(seed: int = 0) -> dict:
    key = jax.random.key(seed)
    ks = jax.random.split(key, 24)
    f32 = jnp.float32
    nrm = lambda k, shape, scale: jax.random.normal(k, shape, f32) * scale
    gain = lambda k, shape: 1.0 + 0.02 * jax.random.normal(k, shape, f32)
    return {
        'x': nrm(ks[0], (BATCH, SEQ, D_MODEL), 1.0),
        'p': nrm(ks[1], (DEPTH, BATCH, SEQ, PLE_DIM), 1.0),
        'norm_mix': gain(ks[2], (DEPTH, D_MODEL)),
        'w_in_even': nrm(ks[3], (N_EVEN, D_MODEL, IN_EVEN), D_MODEL ** -0.5),
        'sinks_a': nrm(ks[4], (N_EVEN, N_Q_HEADS_A), 0.5),
        'vnorm_b': gain(ks[5], (N_EVEN, WIDTH_B)),
        'w_spatial_b': nrm(ks[6], (N_EVEN, N_GROUPS_B, CHUNK_B, CHUNK_B), CHUNK_B ** -0.5),
        'b_spatial_b': 1.0 + nrm(ks[7], (N_EVEN, N_GROUPS_B, CHUNK_B), 0.02),
        'w_out_even': nrm(ks[8], (N_EVEN, MIX_EVEN, D_MODEL), MIX_EVEN ** -0.5),
        'w_in_odd': nrm(ks[9], (N_ODD, D_MODEL, IN_ODD), D_MODEL ** -0.5),
        'lower_bounds_c': nrm(ks[10], (DEPTH, KEY_WIDTH_C), 0.5),
        'onorm_c': gain(ks[11], (N_ODD, WIDTH_C)),
        'w_gate_up_d': nrm(ks[12], (N_ODD, GATE_RANK_D, KEY_WIDTH_D), GATE_RANK_D ** -0.5),
        'b_gate_d': nrm(ks[13], (N_ODD, KEY_WIDTH_D), 0.1),
        'onorm_d': gain(ks[14], (N_ODD, WIDTH_D)),
        'w_out_odd': nrm(ks[15], (N_ODD, MIX_ODD, D_MODEL), MIX_ODD ** -0.5),
        'w_ple_proj': nrm(ks[16], (DEPTH, PLE_DIM, D_MODEL), PLE_DIM ** -0.5),
        'ple_norm': gain(ks[17], (DEPTH, D_MODEL)),
        'ple_gate_norm': gain(ks[18], (DEPTH, D_MODEL)),
        'w_ple_gate': nrm(ks[19], (DEPTH, D_MODEL, D_MODEL), D_MODEL ** -0.5),
        'final_norm': gain(ks[20], (D_MODEL,)),
    }


def reference(x, p, norm_mix, w_in_even, sinks_a, vnorm_b, w_spatial_b, b_spatial_b, w_out_even,
              w_in_odd, lower_bounds_c, onorm_c, w_gate_up_d, b_gate_d, onorm_d, w_out_odd,
              w_ple_proj, ple_norm, ple_gate_norm, w_ple_gate, final_norm):
    h = x
    for i in range(DEPTH):
        hn = rmsnorm(h, norm_mix[i])
        j = i // 2
        if i % 2 == 0:
            h = h + even_mixer(hn, w_in_even[j], sinks_a[j], vnorm_b[j], w_spatial_b[j],
                               b_spatial_b[j], w_out_even[j])
        else:
            h = h + odd_mixer(hn, i, w_in_odd[j], lower_bounds_c, onorm_c[j], w_gate_up_d[j],
                              b_gate_d[j], onorm_d[j], w_out_odd[j])
        e = rmsnorm(p[i] @ w_ple_proj[i], ple_norm[i])
        gate = jax.nn.sigmoid(rmsnorm(h, ple_gate_norm[i]) @ w_ple_gate[i])
        h = h + e * gate
    return rmsnorm(h, final_norm)
```

```cpp
#include <hip/hip_runtime.h>
#include <hip/hip_cooperative_groups.h>
#include <cstdio>
namespace cg = cooperative_groups;

#ifndef ONE_LAUNCH
#define ONE_LAUNCH 1
#endif

#ifndef DUP_PH
#define DUP_PH -1
#endif
#ifndef ONLY_PH
#define ONLY_PH -1
#endif
#define LAS __attribute__((address_space(3)))
typedef unsigned short bf16_t;
typedef short bf16x8 __attribute__((ext_vector_type(8)));
typedef float f32x4 __attribute__((ext_vector_type(4)));
typedef float f32x2 __attribute__((ext_vector_type(2)));
typedef unsigned u32x4 __attribute__((ext_vector_type(4)));
typedef unsigned u32x2 __attribute__((ext_vector_type(2)));

constexpr int SEQ = 16384, DM = 2048;
constexpr int LDZ0 = 5376, LDZ1 = 7424;
constexpr int NPH = 12;
constexpr int LDS_BYTES = 131072 + 16;

constexpr size_t SZ_WIN0 = (size_t)5376 * 2048 * 2, SZ_W2K = (size_t)2048 * 2048 * 2, SZ_WP = (size_t)2048 * 256 * 2, SZ_WIN1 = (size_t)7424 * 2048 * 2;
constexpr size_t WS_WIN0 = 0, WS_WOUT0 = WS_WIN0 + SZ_WIN0, WS_WG0 = WS_WOUT0 + SZ_W2K, WS_WP0 = WS_WG0 + SZ_W2K;
constexpr size_t WS_WIN1 = WS_WP0 + SZ_WP, WS_WOUT1 = WS_WIN1 + SZ_WIN1, WS_WG1 = WS_WOUT1 + SZ_W2K, WS_WP1 = WS_WG1 + SZ_W2K;
constexpr size_t WS_PB = WS_WP1 + SZ_WP;
constexpr size_t WS_HA = WS_PB + (size_t)2 * SEQ * 256 * 2;
constexpr size_t WS_HB = WS_HA + (size_t)SEQ * DM * 2;
constexpr size_t WS_Z = WS_HB + (size_t)SEQ * DM * 2;
constexpr size_t WS_E0 = WS_Z + (size_t)SEQ * LDZ0 * 2;
constexpr size_t WS_STAT = WS_Z + (size_t)SEQ * LDZ1 * 2;
constexpr size_t WS_GLR = WS_STAT + (size_t)9 * SEQ * 4;
constexpr size_t WS_DBUF = WS_GLR + (size_t)SEQ * 16 * 4;
constexpr size_t WS_BAR = WS_DBUF + (size_t)256 * 1536 * 4;
constexpr size_t WS_END = WS_BAR + 16384;

struct Params {
    const float *x, *p, *norm_mix, *w_in_even, *sinks, *vnorm, *w_sp, *b_sp, *w_out_even, *w_in_odd, *lower_bounds, *onorm_c, *w_gate_up, *b_gate, *onorm_d,
        *w_out_odd, *w_ple_proj, *ple_norm, *ple_gate_norm, *w_ple_gate, *final_norm;
    float* out; unsigned char* ws; int ph_lo, ph_hi;
};

__device__ __forceinline__ float bf2f(bf16_t b) { return __uint_as_float(((unsigned)b) << 16); }
typedef __bf16 bf16v2_t __attribute__((ext_vector_type(2)));
__device__ __forceinline__ unsigned cvt_pk_bf16(float lo, float hi) { const f32x2 v = (f32x2){lo, hi}; const bf16v2_t r = __builtin_convertvector(v, bf16v2_t); return __builtin_bit_cast(unsigned, r); }
__device__ __forceinline__ bf16_t f2bf(float f) { return (bf16_t)(cvt_pk_bf16(f, 0.f) & 0xffffu); }
__device__ __forceinline__ float fast_sigmoid(float x) { return __builtin_amdgcn_rcpf(1.0f + __builtin_amdgcn_exp2f(-1.44269504f * x)); }
__device__ __forceinline__ float silu_f(float x) { return x * fast_sigmoid(x); }
__device__ __forceinline__ f32x2 gelu_pk(f32x2 v) {
    const f32x2 av = __builtin_elementwise_abs(v), d = av * 0.2316418882f + 1.0f;
    f32x2 t; t.x = __builtin_amdgcn_rcpf(d.x); t.y = __builtin_amdgcn_rcpf(d.y);
    f32x2 q = t * 0.5307027145f + (-0.7265760135f); q = q * t + 0.7107068705f; q = q * t + (-0.142248368f); q = q * t + 0.127414796f; q = q * t;
    const f32x2 s = (v * v) * (-0.72134752044f);
    f32x2 e; e.x = __builtin_amdgcn_exp2f(s.x); e.y = __builtin_amdgcn_exp2f(s.y);
    const f32x2 m = v * (q * e), r = v - m;
    f32x2 o; o.x = v.x < 0.f ? m.x : r.x; o.y = v.y < 0.f ? m.y : r.y; return o;
}
#define MFMA16(a, b, c) __builtin_amdgcn_mfma_f32_16x16x32_bf16((a), (b), (c), 0, 0, 0)

namespace pg8 {
constexpr int BM = 256, BK = 64, HALF = 128, HTB = HALF * BK * 2, NXCD = 8, WGM = 8;
__host__ __device__ __forceinline__ int lds_byte(int r, int c) { const int st = (r >> 4) * 2 + (c >> 5), rr = r & 15, cc = c & 31, ob = rr * 64 + cc * 2; return st * 1024 + (ob ^ (((ob >> 9) & 1) << 5)); }
__host__ __device__ __forceinline__ void stage_rc(int b, int& R, int& C) { const int st = b / 1024, sb = b % 1024, swz = sb ^ (((sb >> 9) & 1) << 5); R = (st >> 1) * 16 + swz / 64; C = (st & 1) * 32 + (swz % 64) / 2; }
__host__ __device__ __forceinline__ int perm32(int rho) { const int n = rho >> 4, i = rho & 15; return 8 * (i >> 2) + 4 * n + (i & 3); }
struct Unit { int pm, pn; };
struct Gemm { const bf16_t* A; const bf16_t* Bt; int lda, M, N, K; };
struct StaticOrder {
    int nM, nN, nwg, G, c;
    __device__ void init(int M, int N, int G_, int c_) { nM = M / BM; nN = N / BM; nwg = nM * nN; G = G_; c = c_; }
    __device__ bool next(int i, Unit& u) const {
        const long L = (long)i * G + c; if (L >= nwg) return false;
        int wgid = (int)L; { const int q = nwg / NXCD, r = nwg % NXCD, xcd = wgid % NXCD, off = wgid / NXCD; wgid = (xcd < r ? xcd * (q + 1) : r * (q + 1) + (xcd - r) * q) + off; }
        const int nig = WGM * nN, gid = wgid / nig, fm = gid * WGM, gsz = (nM - fm) < WGM ? (nM - fm) : WGM;
        u.pm = fm + ((wgid % nig) % gsz); u.pn = (wgid % nig) / gsz; return true;
    }
};

template <class Epi>
__device__ __forceinline__ void gemm_phase(LAS unsigned char* lds, const Gemm g, const StaticOrder& S, const Epi& E) {
    const int tid = threadIdx.x, wid = __builtin_amdgcn_readfirstlane(tid >> 6), lane = tid & 63, wr = wid >> 2, wc = wid & 3, fr = lane & 15, fq = lane >> 4;
    int K = g.K; asm volatile("" : "+s"(K)); const int nt = K / BK, lda = g.lda;
    unsigned voffA[2], voffB[2];
#pragma unroll
    for (int i = 0; i < 2; ++i) { int R, C; stage_rc(tid * 16 + i * 8192, R, C); const int Rb = Epi::PERM ? ((R & ~31) + perm32(R & 31)) : R;
        voffA[i] = (unsigned)(R * lda + C) * 2u; voffB[i] = (unsigned)(Rb * K + C) * 2u; }
    const size_t kstep = (size_t)(BK * 2);
    const size_t hstepA = (size_t)HALF * lda * 2, hstepB = (size_t)HALF * K * 2;
    const size_t tstepA = 2 * hstepA, tstepB = 2 * hstepB;
    const unsigned ldsw = (unsigned)wid * 1024u;
    const int aoff = lds_byte(wr * 64 + fr, fq * 8), boff = lds_byte(wc * 32 + fr, fq * 8);
#define PG8_SA(b, h) (((b) * 2 + (h)) * HTB)
#define PG8_SB(b, h) ((4 + (b) * 2 + (h)) * HTB)
#define PG8_STAGE(bufoff, gbase, voff) do { _Pragma("unroll") for (int _i = 0; _i < 2; ++_i) \
        __builtin_amdgcn_global_load_lds((const unsigned*)((const char*)(gbase) + (voff)[_i]), (LAS unsigned*)(lds + (bufoff) + ldsw + _i * 8192), 16, 0, 0); } while (0)
#define PG8_LDA(dst, b, h) do { _Pragma("unroll") for (int m = 0; m < 4; ++m) _Pragma("unroll") for (int k = 0; k < 2; ++k) dst[m][k] = *(const LAS bf16x8*)(lds + PG8_SA(b, h) + aoff + m * 2048 + k * 1024); } while (0)
#define PG8_LDB(dst, b, h) do { _Pragma("unroll") for (int n = 0; n < 2; ++n) _Pragma("unroll") for (int k = 0; k < 2; ++k) dst[n][k] = *(const LAS bf16x8*)(lds + PG8_SB(b, h) + boff + n * 2048 + k * 1024); } while (0)
#define PG8_MMA(ai, bj, At, Bt) do { __builtin_amdgcn_s_setprio(1); _Pragma("unroll") for (int m = 0; m < 4; ++m) _Pragma("unroll") for (int n = 0; n < 2; ++n) _Pragma("unroll") for (int k = 0; k < 2; ++k) \
        acc[ai][bj][m][n] = __builtin_amdgcn_mfma_f32_16x16x32_bf16(Bt[n][k], At[m][k], acc[ai][bj][m][n], 0, 0, 0); __builtin_amdgcn_s_setprio(0); } while (0)
#define PG8_WAIT_V(n) asm volatile("s_waitcnt vmcnt(" #n ")" ::: "memory")
#define PG8_WAIT_L(n) asm volatile("s_waitcnt lgkmcnt(" #n ")" ::: "memory")
#define PG8_BAR __builtin_amdgcn_s_barrier()
#define PG8_SCHED __builtin_amdgcn_sched_barrier(0)
    Unit cur, nxt, pu; int ui = 0;
    if (!S.next(0, cur)) return;
    pu = cur; float psum[8] = {0.f, 0.f, 0.f, 0.f, 0.f, 0.f, 0.f, 0.f}; bool pend = false;
    f32x4 acc[2][2][4][2];
#pragma unroll
    for (int a = 0; a < 2; ++a)
#pragma unroll
        for (int b = 0; b < 2; ++b)
#pragma unroll
            for (int m = 0; m < 4; ++m)
#pragma unroll
                for (int n = 0; n < 2; ++n) acc[a][b][m][n] = (f32x4){0.f, 0.f, 0.f, 0.f};
    bf16x8 At[4][2], B0[2][2], B1[2][2];
    const char* cA = (const char*)g.A + (size_t)cur.pm * tstepA; const char* cB = (const char*)g.Bt + (size_t)cur.pn * tstepB;
    PG8_STAGE(PG8_SB(0, 0), cB, voffB); PG8_STAGE(PG8_SA(0, 0), cA, voffA); PG8_STAGE(PG8_SB(0, 1), cB + hstepB, voffB); PG8_STAGE(PG8_SA(0, 1), cA + hstepA, voffA);
    if (wr == 1) PG8_BAR;
    PG8_WAIT_V(4); PG8_BAR;
    PG8_STAGE(PG8_SB(1, 0), cB + kstep, voffB); PG8_STAGE(PG8_SA(1, 0), cA + kstep, voffA); PG8_STAGE(PG8_SB(1, 1), cB + hstepB + kstep, voffB);
    PG8_WAIT_V(6); PG8_BAR;
    for (;;) {
        const bool has_next = S.next(ui + 1, nxt);
        const char* nA = has_next ? (const char*)g.A + (size_t)nxt.pm * tstepA : cA; const char* nB = has_next ? (const char*)g.Bt + (size_t)nxt.pn * tstepB : cB;
#pragma clang loop unroll(disable)
        for (int t = 0; t < nt; t += 2) {
            const bool last = (t == nt - 2);
            if (pend && t == 2) { E.flush(psum, pu, wr, fr, fq); pend = false; }
            const char* a1 = cA + (size_t)(t + 1) * kstep;
            const char* a2 = last ? nA : cA + (size_t)(t + 2) * kstep; const char* b2 = last ? nB : cB + (size_t)(t + 2) * kstep;
            const char* a3 = a2 + kstep; const char* b3 = b2 + kstep;
            PG8_LDB(B0, 0, 0); PG8_SCHED; PG8_LDA(At, 0, 0); PG8_STAGE(PG8_SA(1, 1), a1 + hstepA, voffA);
            PG8_WAIT_L(8); PG8_BAR; PG8_WAIT_L(0); PG8_MMA(0, 0, At, B0); PG8_BAR; PG8_SCHED;
            PG8_LDB(B1, 0, 1); PG8_STAGE(PG8_SB(0, 0), b2, voffB);
            PG8_BAR; PG8_WAIT_L(0); PG8_MMA(0, 1, At, B1); PG8_BAR;
            PG8_LDA(At, 0, 1); PG8_STAGE(PG8_SA(0, 0), a2, voffA);
            PG8_BAR; PG8_WAIT_L(0); PG8_MMA(1, 0, At, B0); PG8_BAR; PG8_SCHED;
            PG8_STAGE(PG8_SB(0, 1), b2 + hstepB, voffB);
            PG8_WAIT_V(6); PG8_BAR; PG8_MMA(1, 1, At, B1); PG8_BAR;
            PG8_LDB(B0, 1, 0); PG8_SCHED; PG8_LDA(At, 1, 0); PG8_STAGE(PG8_SA(0, 1), a2 + hstepA, voffA);
            PG8_WAIT_L(8); PG8_BAR; PG8_WAIT_L(0); PG8_MMA(0, 0, At, B0); PG8_BAR; PG8_SCHED;
            PG8_LDB(B1, 1, 1); PG8_STAGE(PG8_SB(1, 0), b3, voffB);
            PG8_BAR; PG8_WAIT_L(0); PG8_MMA(0, 1, At, B1); PG8_BAR;
            PG8_LDA(At, 1, 1); PG8_STAGE(PG8_SA(1, 0), a3, voffA);
            PG8_BAR; PG8_WAIT_L(0); PG8_MMA(1, 0, At, B0); PG8_BAR; PG8_SCHED;
            PG8_STAGE(PG8_SB(1, 1), b3 + hstepB, voffB);
            PG8_WAIT_V(6); PG8_BAR; PG8_MMA(1, 1, At, B1); PG8_BAR;
        }
        pend = E(acc, cur, wr, wc, fr, fq, psum); pu = cur;
        if (!has_next) { if (pend) E.flush(psum, pu, wr, fr, fq); break; }
#pragma unroll
        for (int a = 0; a < 2; ++a)
#pragma unroll
            for (int b = 0; b < 2; ++b)
#pragma unroll
                for (int m = 0; m < 4; ++m)
#pragma unroll
                    for (int n = 0; n < 2; ++n) acc[a][b][m][n] = (f32x4){0.f, 0.f, 0.f, 0.f};
        cur = nxt; cA = nA; cB = nB; ++ui;
    }
    PG8_WAIT_V(0);
    if (wr == 0) PG8_BAR;
    PG8_BAR;
#undef PG8_SA
#undef PG8_SB
#undef PG8_STAGE
#undef PG8_LDA
#undef PG8_LDB
#undef PG8_MMA
#undef PG8_WAIT_V
#undef PG8_WAIT_L
#undef PG8_BAR
#undef PG8_SCHED
}
}

template <int MODE> struct Epi {
    static constexpr bool PERM = true;
    bf16_t* o16; int ld16; float* H; const float* resid; const float* ss_in; float* ss_out; const bf16_t* E; const float* ssE; const float* pnorm; float* glr; int dummy; const bf16_t* resid16;
    __device__ __forceinline__ void flush(const float (&sums)[8], const pg8::Unit& u, int wr, int fr, int fq) const {
        if (fq == 0) {
#pragma unroll
            for (int q = 0; q < 8; ++q) atomicAdd(ss_out + u.pm * 256 + wr * 64 + fr + (q >> 2) * 128 + (q & 3) * 16, sums[q]);
        }
    }
    __device__ __forceinline__ bool operator()(const f32x4 (&acc)[2][2][4][2], const pg8::Unit& u, int wr, int wc, int fr, int fq, float (&sums)[8]) const {
        const int row0 = u.pm * 256 + wr * 64 + fr, col0 = u.pn * 256 + wc * 32 + 8 * fq;
        int kind = 0;
        if (MODE == 1) { const int pn = u.pn; kind = pn < 4 ? 0 : (pn == 4 ? 1 : (pn < 9 ? 2 : (pn < 13 ? 3 : (pn < 17 ? 4 : 2)))); }
        if (MODE == 5) { const int pn = u.pn; kind = ((pn >= 8 && pn < 12) || (pn >= 16 && pn < 20)) ? 2 : 1; }
        float rsv[2][4], rEv[2][4];
#pragma unroll
        for (int ai = 0; ai < 2; ++ai)
#pragma unroll
            for (int m = 0; m < 4; ++m) {
                const int row = row0 + ai * 128 + m * 16;
                rsv[ai][m] = (MODE == 1 || MODE == 4 || MODE == 5) ? ss_in[row] : 0.f;
                rEv[ai][m] = (MODE == 4) ? ssE[row] : 0.f;
            }
        f32x4 pnv[2][2];
        if (MODE == 4) {
#pragma unroll
            for (int bj = 0; bj < 2; ++bj) { pnv[bj][0] = *(const f32x4*)(pnorm + col0 + bj * 128); pnv[bj][1] = *(const f32x4*)(pnorm + col0 + bj * 128 + 4); }
        }
#pragma unroll
        for (int ai = 0; ai < 2; ++ai)
#pragma unroll
            for (int m = 0; m < 4; ++m) { rsv[ai][m] = rsqrtf(rsv[ai][m] * (1.f / 2048.f) + 1e-6f); rEv[ai][m] = rsqrtf(rEv[ai][m] * (1.f / 2048.f) + 1e-6f); }
#pragma unroll
        for (int ai = 0; ai < 2; ++ai)
#pragma unroll
        for (int mh = 0; mh < 2; ++mh) {
            u32x4 rw[4][2], ew[4][2]; f32x4 rf[4][2][2];
            if (MODE == 3 || MODE == 4) {
#pragma unroll
                for (int m = 2 * mh; m < 2 * mh + 2; ++m)
#pragma unroll
                    for (int bj = 0; bj < 2; ++bj) {
                        const size_t off = (size_t)(row0 + ai * 128 + m * 16) * DM + col0 + bj * 128;
                        if (MODE == 4) { rw[m][bj] = *(const u32x4*)(resid16 + off); ew[m][bj] = *(const u32x4*)(E + off); }
                        if (MODE == 3) {
                            if (resid16 != nullptr) rw[m][bj] = *(const u32x4*)(resid16 + off);
                            else { rf[m][bj][0] = *(const f32x4*)(resid + off); rf[m][bj][1] = *(const f32x4*)(resid + off + 4); }
                        }
                    }
            }
#pragma unroll
            for (int m = 2 * mh; m < 2 * mh + 2; ++m) {
                const int row = row0 + ai * 128 + m * 16;
                const float rs = rsv[ai][m], rE = rEv[ai][m];
                float ssq = 0.f;
#pragma unroll
                for (int bj = 0; bj < 2; ++bj) {
                    const int col = col0 + bj * 128;
                    const f32x4 a0 = acc[ai][bj][m][0], a1 = acc[ai][bj][m][1];
                    float v[8] = {a0[0], a0[1], a0[2], a0[3], a1[0], a1[1], a1[2], a1[3]};
                    if (MODE == 1) {
#pragma unroll
                        for (int e = 0; e < 8; ++e) v[e] *= rs;
                        if (kind == 0) {
#pragma unroll
                            for (int e = 0; e < 8; ++e) v[e] *= 0.125f * 1.44269504f;
                        } else if (kind == 2) {
#pragma unroll
                            for (int e = 0; e < 8; ++e) v[e] = silu_f(v[e]);
                        } else if (kind >= 3) {
#pragma unroll
                            for (int e = 0; e < 8; e += 2) { f32x2 r = gelu_pk((f32x2){v[e], v[e + 1]}); v[e] = r.x; v[e + 1] = r.y; }
                            if (kind == 4) {
#pragma unroll
                                for (int e = 0; e < 8; ++e) ssq += v[e] * v[e];
                            }
                        }
                    }
                    if (MODE == 2) {
#pragma unroll
                        for (int e = 0; e < 8; ++e) ssq += v[e] * v[e];
                    }
                    if (MODE == 3) {
                        if (resid16 != nullptr) {
#pragma unroll
                            for (int e = 0; e < 4; ++e) { v[2 * e] += __uint_as_float(rw[m][bj][e] << 16); v[2 * e + 1] += __uint_as_float(rw[m][bj][e] & 0xffff0000u); }
                        } else {
#pragma unroll
                            for (int e = 0; e < 4; ++e) { v[e] += rf[m][bj][0][e]; v[e + 4] += rf[m][bj][1][e]; }
                        }
#pragma unroll
                        for (int e = 0; e < 8; ++e) ssq += v[e] * v[e];
                    }
                    if (MODE == 4) {
                        const float nv[8] = {pnv[bj][0][0], pnv[bj][0][1], pnv[bj][0][2], pnv[bj][0][3], pnv[bj][1][0], pnv[bj][1][1], pnv[bj][1][2], pnv[bj][1][3]};
#pragma unroll
                        for (int e = 0; e < 8; ++e) {
                            const float hv = (e & 1) ? __uint_as_float(rw[m][bj][e >> 1] & 0xffff0000u) : __uint_as_float(rw[m][bj][e >> 1] << 16);
                            const float evv = (e & 1) ? __uint_as_float(ew[m][bj][e >> 1] & 0xffff0000u) : __uint_as_float(ew[m][bj][e >> 1] << 16);
                            const float gte = fast_sigmoid(v[e] * rs); v[e] = hv + evv * rE * nv[e] * gte; ssq += v[e] * v[e]; }
                    }
                    if (MODE == 5) {
#pragma unroll
                        for (int e = 0; e < 8; ++e) v[e] *= rs;
                        if (kind == 2) {
#pragma unroll
                            for (int e = 0; e < 8; ++e) v[e] = silu_f(v[e]);
                        }
                    }
                    if (!dummy || v[0] == 12345.678f) {
                        u32x4 w; w.x = cvt_pk_bf16(v[0], v[1]); w.y = cvt_pk_bf16(v[2], v[3]); w.z = cvt_pk_bf16(v[4], v[5]); w.w = cvt_pk_bf16(v[6], v[7]);
                        *(u32x4*)(o16 + (size_t)row * ld16 + col) = w;
                    }
                }
                if (MODE == 2 || MODE == 3 || MODE == 4 || (MODE == 1 && kind == 4)) {
                    ssq += __shfl_xor(ssq, 16); ssq += __shfl_xor(ssq, 32);
                    sums[ai * 4 + m] = ssq;
                }
            }
        }
        return (MODE == 2 || MODE == 3 || MODE == 4 || (MODE == 1 && kind == 4));
    }
};

__device__ __forceinline__ int map_in1(int n) {
    if (n < 2048) return n;
    if (n < 4096) return n + 1024;
    if (n < 5120) return n + 2064;
    if (n < 6144) return n - 3072;
    if (n < 7184) return n - 1024;
    return -1;
}
__device__ __forceinline__ void wtrans_tile(const float* W, int K, int Nsrc, bf16_t* Wt, const float* gain, int mapk, int tk, int tn, LAS float* tl) {
    const int tid = threadIdx.x, tx = tid & 255, ty = tid >> 8;
    const int k0 = tk * 64, n0 = tn * 256;
    int sc = n0 + tx; if (mapk) sc = map_in1(sc);
    float v[32];
#pragma unroll
    for (int i = 0; i < 32; ++i) { const int kk = ty + 2 * i; v[i] = (sc >= 0) ? W[(size_t)(k0 + kk) * Nsrc + sc] : 0.f; }
    if (gain) {
#pragma unroll
        for (int i = 0; i < 32; ++i) v[i] *= gain[k0 + ty + 2 * i];
    }
#pragma unroll
    for (int i = 0; i < 32; ++i) tl[(ty + 2 * i) * 257 + tx] = v[i];
    __syncthreads();
#pragma unroll
    for (int p = 0; p < 4; ++p) {
        const int n = p * 64 + (tid >> 3), seg = (tid & 7) * 8; float o[8];
#pragma unroll
        for (int j = 0; j < 8; ++j) o[j] = tl[(seg + j) * 257 + n];
        u32x4 w; w.x = cvt_pk_bf16(o[0], o[1]); w.y = cvt_pk_bf16(o[2], o[3]); w.z = cvt_pk_bf16(o[4], o[5]); w.w = cvt_pk_bf16(o[6], o[7]);
        *(u32x4*)(Wt + (size_t)(n0 + n) * K + k0 + seg) = w;
    }
    __syncthreads();
}
__device__ __forceinline__ void phase_wconv(const Params& P, LAS unsigned char* lds, int gbeg, int gend, int bid, int nb);
__device__ __forceinline__ void phase_prep(const Params& P, LAS unsigned char* lds, int bid, int nb) {
    const int tid = threadIdx.x, wid = tid >> 6, lane = tid & 63;
    unsigned char* ws = P.ws;
    float* stat = (float*)(ws + WS_STAT);
    for (int i = bid * 512 + tid; i < 7 * SEQ; i += nb * 512) stat[SEQ + i] = 0.f;
    { bf16_t* xb = (bf16_t*)(ws + WS_HA);
      for (int row = bid * 16 + wid * 2; row < SEQ; row += nb * 16) {
          const float* xr = P.x + (size_t)row * DM; float s0 = 0.f, s1 = 0.f;
          f32x4 va[8], vb[8];
#pragma unroll
          for (int i = 0; i < 8; ++i) { va[i] = *(const f32x4*)(xr + lane * 4 + 256 * i); vb[i] = *(const f32x4*)(xr + DM + lane * 4 + 256 * i); }
#pragma unroll
          for (int i = 0; i < 8; ++i) {
              s0 += va[i][0] * va[i][0] + va[i][1] * va[i][1] + va[i][2] * va[i][2] + va[i][3] * va[i][3];
              s1 += vb[i][0] * vb[i][0] + vb[i][1] * vb[i][1] + vb[i][2] * vb[i][2] + vb[i][3] * vb[i][3];
              u32x2 w; w.x = cvt_pk_bf16(va[i][0], va[i][1]); w.y = cvt_pk_bf16(va[i][2], va[i][3]); *(u32x2*)(xb + (size_t)row * DM + lane * 4 + 256 * i) = w;
              u32x2 w2; w2.x = cvt_pk_bf16(vb[i][0], vb[i][1]); w2.y = cvt_pk_bf16(vb[i][2], vb[i][3]); *(u32x2*)(xb + (size_t)(row + 1) * DM + lane * 4 + 256 * i) = w2; }
#pragma unroll
          for (int o = 1; o < 64; o <<= 1) { s0 += __shfl_xor(s0, o); s1 += __shfl_xor(s1, o); }
          if (lane == 0) { stat[row] = s0; stat[row + 1] = s1; }
      } }
    { bf16_t* pb = (bf16_t*)(ws + WS_PB);
      const size_t total = (size_t)2 * SEQ * 256, stride = (size_t)nb * 512 * 4;
      for (size_t i0 = (size_t)(bid * 512 + tid) * 4; i0 < total; i0 += stride * 8) {
          f32x4 v[8];
#pragma unroll
          for (int q = 0; q < 8; ++q) { const size_t i = i0 + stride * q; v[q] = (i < total) ? *(const f32x4*)(P.p + i) : (f32x4){0.f, 0.f, 0.f, 0.f}; }
#pragma unroll
          for (int q = 0; q < 8; ++q) { const size_t i = i0 + stride * q; if (i < total) { u32x2 w; w.x = cvt_pk_bf16(v[q][0], v[q][1]); w.y = cvt_pk_bf16(v[q][2], v[q][3]); *(u32x2*)(pb + i) = w; } }
      } }
    phase_wconv(P, lds, 0, 32 * 21 + 256 + 256 + 32, bid, nb);
}
__device__ __forceinline__ void phase_wconv(const Params& P, LAS unsigned char* lds, int gbeg, int gend, int bid, int nb) {
    unsigned char* ws = P.ws;
    { LAS float* tl = (LAS float*)lds;
      const int c0 = 32 * 21, c1 = c0 + 256, c2 = c1 + 256, c3 = c2 + 32, c4 = c3 + 32 * 29, c5 = c4 + 256, c6 = c5 + 256;
      for (int g = gbeg + bid; g < gend; g += nb) {
          if (g < c0) wtrans_tile(P.w_in_even, 2048, 5376, (bf16_t*)(ws + WS_WIN0), P.norm_mix, 0, g % 32, g / 32, tl);
          else if (g < c1) { const int t = g - c0; wtrans_tile(P.w_out_even, 2048, 2048, (bf16_t*)(ws + WS_WOUT0), nullptr, 0, t % 32, t / 32, tl); }
          else if (g < c2) { const int t = g - c1; wtrans_tile(P.w_ple_gate, 2048, 2048, (bf16_t*)(ws + WS_WG0), P.ple_gate_norm, 0, t % 32, t / 32, tl); }
          else if (g < c3) { const int t = g - c2; wtrans_tile(P.w_ple_proj, 256, 2048, (bf16_t*)(ws + WS_WP0), nullptr, 0, t % 4, t / 4, tl); }
          else if (g < c4) { const int t = g - c3; wtrans_tile(P.w_in_odd, 2048, 7184, (bf16_t*)(ws + WS_WIN1), P.norm_mix + DM, 1, t % 32, t / 32, tl); }
          else if (g < c5) { const int t = g - c4; wtrans_tile(P.w_out_odd, 2048, 2048, (bf16_t*)(ws + WS_WOUT1), nullptr, 0, t % 32, t / 32, tl); }
          else if (g < c6) { const int t = g - c5; wtrans_tile(P.w_ple_gate + (size_t)DM * DM, 2048, 2048, (bf16_t*)(ws + WS_WG1), P.ple_gate_norm + DM, 0, t % 32, t / 32, tl); }
          else { const int t = g - c6; wtrans_tile(P.w_ple_proj + (size_t)256 * DM, 256, 2048, (bf16_t*)(ws + WS_WP1), nullptr, 0, t % 4, t / 4, tl); }
      } }
}

__device__ __forceinline__ void attn_unit(const Params& P, LAS unsigned char* lds, int n, int g) {
    const int tid = threadIdx.x, w = tid >> 6, lane = tid & 63, l15 = lane & 15, quad = lane >> 4;
    const bf16_t* Z = (const bf16_t*)(P.ws + WS_Z);
    bf16_t* Y = (bf16_t*)(P.ws + WS_HA);
    constexpr int KS = 0, VT = 36864, PB = 70656;
#pragma unroll
    for (int r = 0; r < 4; ++r) {
        { const int idx = tid + 512 * r, key = idx >> 3, c8 = idx & 7; u32x4 v = (u32x4){0u, 0u, 0u, 0u};
          if (n > 0 || key >= 128) v = *(const u32x4*)(Z + (size_t)(128 * (n - 1) + key) * LDZ0 + 1024 + g * 64 + c8 * 8);
          *(LAS u32x4*)(lds + KS + key * 144 + c8 * 16) = v; }
        { const int idx = tid + 512 * r, key = idx & 255, c8 = idx >> 8; u32x4 v = (u32x4){0u, 0u, 0u, 0u};
          if (n > 0 || key >= 128) v = *(const u32x4*)(Z + (size_t)(128 * (n - 1) + key) * LDZ0 + 1152 + g * 64 + c8 * 8);
#pragma unroll
          for (int e = 0; e < 4; ++e) { *(LAS bf16_t*)(lds + VT + (c8 * 8 + 2 * e) * 528 + key * 2) = (bf16_t)(v[e] & 0xffffu); *(LAS bf16_t*)(lds + VT + (c8 * 8 + 2 * e + 1) * 528 + key * 2) = (bf16_t)(v[e] >> 16); } }
    }
    __syncthreads();
    const int hq = g * 8 + w;
    const float sink = P.sinks[hq] * 1.44269504f;
    LAS unsigned char* pw = lds + PB + w * 5376;
    bf16x8 q0n, q1n; u32x2 gwn[4];
    { const size_t qrow = (size_t)(128 * n + l15);
      q0n = *(const bf16x8*)(Z + qrow * LDZ0 + hq * 64 + quad * 8); q1n = *(const bf16x8*)(Z + qrow * LDZ0 + hq * 64 + 32 + quad * 8);
#pragma unroll
      for (int nt = 0; nt < 4; ++nt) gwn[nt] = *(const u32x2*)(Z + qrow * LDZ0 + 1280 + hq * 64 + 16 * nt + quad * 4); }
    for (int rg = 0; rg < 8; ++rg) {
        const int kt0 = rg < 6 ? rg : 6;
        const bf16x8 q0 = q0n, q1 = q1n;
        u32x2 gwc[4];
#pragma unroll
        for (int nt = 0; nt < 4; ++nt) gwc[nt] = gwn[nt];
        if (rg < 7) {
            const size_t qrow = (size_t)(128 * n + 16 * (rg + 1) + l15);
            q0n = *(const bf16x8*)(Z + qrow * LDZ0 + hq * 64 + quad * 8); q1n = *(const bf16x8*)(Z + qrow * LDZ0 + hq * 64 + 32 + quad * 8);
#pragma unroll
            for (int nt = 0; nt < 4; ++nt) gwn[nt] = *(const u32x2*)(Z + qrow * LDZ0 + 1280 + hq * 64 + 16 * nt + quad * 4);
        }
        f32x4 s[10];
#pragma unroll
        for (int t = 0; t < 10; ++t) {
            const int key = 16 * (kt0 + t) + l15;
            const bf16x8 k0 = *(const LAS bf16x8*)(lds + KS + key * 144 + quad * 16), k1 = *(const LAS bf16x8*)(lds + KS + key * 144 + 64 + quad * 16);
            f32x4 a = (f32x4){0.f, 0.f, 0.f, 0.f};
            a = MFMA16(q0, k0, a); a = MFMA16(q1, k1, a);
            s[t] = a;
        }
        float mx[4], sm[4];
        if (n > 0 && rg < 7) {
#pragma unroll
            for (int j = 0; j < 4; ++j) { const int qr = quad * 4 + j;
                s[0][j] = (l15 > qr) ? s[0][j] : -1e30f; s[8][j] = (l15 <= qr) ? s[8][j] : -1e30f; s[9][j] = -1e30f; }
        } else {
#pragma unroll
            for (int j = 0; j < 4; ++j) { const int qi = 16 * rg + quad * 4 + j;
#pragma unroll
                for (int t = 0; t < 10; ++t) { const int kj = 16 * (kt0 + t) + l15; const bool valid = (kj > qi) && (kj <= qi + 128) && (n > 0 || kj >= 128);
                    s[t][j] = valid ? s[t][j] : -1e30f; } }
        }
#pragma unroll
        for (int j = 0; j < 4; ++j) {
            float m = -1e30f;
#pragma unroll
            for (int t = 0; t < 10; ++t) m = fmaxf(m, s[t][j]);
            m = fmaxf(m, __shfl_xor(m, 1)); m = fmaxf(m, __shfl_xor(m, 2)); m = fmaxf(m, __shfl_xor(m, 4)); m = fmaxf(m, __shfl_xor(m, 8));
            m = fmaxf(m, sink); mx[j] = m;
            float su = 0.f;
#pragma unroll
            for (int t = 0; t < 10; ++t) { const float pv = __builtin_amdgcn_exp2f(s[t][j] - m); s[t][j] = pv; su += pv; }
            su += __shfl_xor(su, 1); su += __shfl_xor(su, 2); su += __shfl_xor(su, 4); su += __shfl_xor(su, 8);
            su += __builtin_amdgcn_exp2f(sink - m); sm[j] = 1.0f / su;
        }
#pragma unroll
        for (int t = 0; t < 10; ++t)
#pragma unroll
            for (int j = 0; j < 4; ++j) *(LAS bf16_t*)(pw + (quad * 4 + j) * 336 + (16 * t + l15) * 2) = f2bf(s[t][j]);
        f32x4 o[4];
#pragma unroll
        for (int nt = 0; nt < 4; ++nt) o[nt] = (f32x4){0.f, 0.f, 0.f, 0.f};
#pragma unroll
        for (int s5 = 0; s5 < 5; ++s5) {
            const bf16x8 pa = *(const LAS bf16x8*)(pw + l15 * 336 + (32 * s5 + quad * 8) * 2);
#pragma unroll
            for (int nt = 0; nt < 4; ++nt) {
                const bf16x8 vb = *(const LAS bf16x8*)(lds + VT + (16 * nt + l15) * 528 + (16 * kt0 + 32 * s5 + quad * 8) * 2);
                o[nt] = MFMA16(vb, pa, o[nt]);
            }
        }
        float smq;
        { const int src = (l15 >> 2) << 4; const float t0 = __shfl(sm[0], src), t1 = __shfl(sm[1], src), t2 = __shfl(sm[2], src), t3 = __shfl(sm[3], src);
          const int jj = l15 & 3; smq = jj == 0 ? t0 : (jj == 1 ? t1 : (jj == 2 ? t2 : t3)); }
        { const size_t row = (size_t)(128 * n + 16 * rg + l15);
#pragma unroll
          for (int nt = 0; nt < 4; ++nt) {
              const int d0 = 16 * nt + quad * 4;
              const u32x2 gw = gwc[nt];
              u32x2 yw;
              yw.x = cvt_pk_bf16(o[nt][0] * smq * __uint_as_float(gw.x << 16), o[nt][1] * smq * __uint_as_float(gw.x & 0xffff0000u));
              yw.y = cvt_pk_bf16(o[nt][2] * smq * __uint_as_float(gw.y << 16), o[nt][3] * smq * __uint_as_float(gw.y & 0xffff0000u));
              *(u32x2*)(Y + row * DM + hq * 64 + d0) = yw;
          } }
    }
    __syncthreads();
}
__device__ __forceinline__ void gmlp_unit(const Params& P, LAS unsigned char* lds, int n, int g) {
    const int tid = threadIdx.x, w = tid >> 6, lane = tid & 63, l15 = lane & 15, quad = lane >> 4;
    const bf16_t* Z = (const bf16_t*)(P.ws + WS_Z);
    bf16_t* Y = (bf16_t*)(P.ws + WS_HA);
    const float* ssv = (const float*)(P.ws + WS_STAT) + SEQ;
    const int trow = 16 * w + l15;
    const float* wsp = P.w_sp + ((size_t)g * 128 + trow) * 128;
    f32x4 wq[4][2];
#pragma unroll
    for (int ks = 0; ks < 4; ++ks) {
        wq[ks][0] = (f32x4){0.f, 0.f, 0.f, 0.f}; wq[ks][1] = (f32x4){0.f, 0.f, 0.f, 0.f};
        if (32 * ks <= 16 * w + 15) { wq[ks][0] = *(const f32x4*)(wsp + 32 * ks + quad * 8); wq[ks][1] = *(const f32x4*)(wsp + 32 * ks + quad * 8 + 4); }
    }
    u32x2 uwv[8], gwv[8];
#pragma unroll
    for (int nt = 0; nt < 8; ++nt) {
        const size_t row = (size_t)(128 * n + trow); const int c0 = g * 128 + 16 * nt + quad * 4;
        uwv[nt] = *(const u32x2*)(Z + row * LDZ0 + 2304 + c0); gwv[nt] = *(const u32x2*)(Z + row * LDZ0 + 4352 + c0);
    }
    const float bs = P.b_sp[g * 128 + trow];
#pragma unroll
    for (int r = 0; r < 4; ++r) {
        const int idx = tid + 512 * r, s = idx & 127, c8 = idx >> 7;
        const u32x4 v = *(const u32x4*)(Z + (size_t)(128 * n + s) * LDZ0 + 3328 + g * 128 + c8 * 8);
        const float rinv = rsqrtf(ssv[128 * n + s] * (1.f / 1024.f) + 1e-6f);
#pragma unroll
        for (int e = 0; e < 4; ++e) {
            const int c = c8 * 8 + 2 * e;
            const float lo = __uint_as_float(v[e] << 16) * rinv * P.vnorm[g * 128 + c], hi = __uint_as_float(v[e] & 0xffff0000u) * rinv * P.vnorm[g * 128 + c + 1];
            *(LAS bf16_t*)(lds + c * 272 + s * 2) = f2bf(lo); *(LAS bf16_t*)(lds + (c + 1) * 272 + s * 2) = f2bf(hi);
        }
    }
    __syncthreads();
    f32x4 acc[8];
#pragma unroll
    for (int nt = 0; nt < 8; ++nt) acc[nt] = (f32x4){0.f, 0.f, 0.f, 0.f};
#pragma unroll
    for (int ks = 0; ks < 4; ++ks) {
        if (32 * ks <= 16 * w + 15) {
            const int s0 = 32 * ks + quad * 8;
            const f32x4 w0 = wq[ks][0], w1 = wq[ks][1];
            float wv[8] = {w0[0], w0[1], w0[2], w0[3], w1[0], w1[1], w1[2], w1[3]};
#pragma unroll
            for (int e = 0; e < 8; ++e) if (s0 + e > trow) wv[e] = 0.f;
            u32x4 aw; aw.x = cvt_pk_bf16(wv[0], wv[1]); aw.y = cvt_pk_bf16(wv[2], wv[3]); aw.z = cvt_pk_bf16(wv[4], wv[5]); aw.w = cvt_pk_bf16(wv[6], wv[7]);
            const bf16x8 af = __builtin_bit_cast(bf16x8, aw);
#pragma unroll
            for (int nt = 0; nt < 8; ++nt) { const bf16x8 bfv = *(const LAS bf16x8*)(lds + (16 * nt + l15) * 272 + s0 * 2); acc[nt] = MFMA16(bfv, af, acc[nt]); }
        }
    }
    { const int t = 16 * w + l15; const size_t row = (size_t)(128 * n + t);
#pragma unroll
      for (int nt = 0; nt < 8; ++nt) {
          const int c0 = g * 128 + 16 * nt + quad * 4;
          const u32x2 uw = uwv[nt], gw = gwv[nt];
          u32x2 yw;
          yw.x = cvt_pk_bf16(__uint_as_float(uw.x << 16) * (acc[nt][0] + bs) * __uint_as_float(gw.x << 16), __uint_as_float(uw.x & 0xffff0000u) * (acc[nt][1] + bs) * __uint_as_float(gw.x & 0xffff0000u));
          yw.y = cvt_pk_bf16(__uint_as_float(uw.y << 16) * (acc[nt][2] + bs) * __uint_as_float(gw.y << 16), __uint_as_float(uw.y & 0xffff0000u) * (acc[nt][3] + bs) * __uint_as_float(gw.y & 0xffff0000u));
          *(u32x2*)(Y + row * DM + 1024 + c0) = yw;
      } }
    __syncthreads();
}
__device__ __forceinline__ void phase_mix0(const Params& P, LAS unsigned char* lds, int bid, int nb) {
    for (int u = bid; u < 256; u += nb) attn_unit(P, lds, u >> 1, u & 1);
    for (int u = bid; u < 1024; u += nb) gmlp_unit(P, lds, u >> 3, u & 7);
}

struct FrontC { float lbv, bg; float wu[16]; };
template <int MIX>
__device__ __forceinline__ void front_consts(const Params& P, int h, FrontC& C) {
    const int c = h * 128 + (threadIdx.x & 127);
    C.lbv = 0.f; C.bg = 0.f;
    if (MIX == 0) C.lbv = __builtin_amdgcn_rcpf(1.0f + __expf(P.lower_bounds[c] - P.lower_bounds[1024 + c]));
    else {
#pragma unroll
        for (int r = 0; r < 16; ++r) C.wu[r] = P.w_gate_up[r * 512 + c];
        C.bg = P.b_gate[c];
    }
}
template <int MIX>
__device__ __forceinline__ void front_load(const Params& P, int n, int h, float (&zr)[16], f32x4& gq) {
    const int tid = threadIdx.x, kk = tid & 127, i = tid >> 7;
    const bf16_t* Z = (const bf16_t*)(P.ws + WS_Z);
    const int col = (MIX ? 3584 : 1024) + h * 128 + kk;
#pragma unroll
    for (int tt = 0; tt < 16; ++tt) zr[tt] = bf2f(Z[(size_t)(64 * n + 16 * i + tt) * LDZ1 + col]);
    if (MIX) {
        const int iu = __builtin_amdgcn_readfirstlane(i);
        const float* glr = (const float*)(P.ws + WS_GLR) + (size_t)(64 * n + 16 * iu) * 16;
        gq = *(const f32x4*)(glr + 4 * (threadIdx.x & 63));
    }
}
template <int MIX>
__device__ __forceinline__ void front_compute(LAS unsigned char* lds, const FrontC& C, const float (&zr)[16], const f32x4& gq, float (&loc)[16], float (&kv)[16], float (&o)[5]) {
    const int tid = threadIdx.x, kk = tid & 127, i = tid >> 7;
    LAS float* segtot = (LAS float*)lds;
    float run = 0.f;
    if (MIX == 0) {
        const float lbv = C.lbv;
#pragma unroll
        for (int tt = 0; tt < 16; ++tt) {
            const float z = zr[tt];
            const float en = __expf(-fabsf(z)), r = __builtin_amdgcn_rcpf(1.0f + en);
            const float sg = z >= 0.f ? r : en * r, omsg = z >= 0.f ? en * r : r;
            const float f = lbv + (1.0f - lbv) * sg;
            run += __logf(f); loc[tt] = run; kv[tt] = (1.0f - lbv) * omsg;
        }
    } else {
#pragma unroll
        for (int tt = 0; tt < 16; ++tt) {
            float xg = C.bg;
#pragma unroll
            for (int r = 0; r < 16; ++r) {
                const float gv = __int_as_float(__builtin_amdgcn_readlane(__float_as_int(gq[r & 3]), 4 * tt + (r >> 2)));
                xg += gv * C.wu[r];
            }
            const float ls = fminf(xg, 0.f) - __logf(1.0f + __expf(-fabsf(xg)));
            run += ls * (1.0f / 16.0f); loc[tt] = run; kv[tt] = zr[tt];
        }
    }
    segtot[i * 128 + kk] = run;
    __syncthreads();
    o[0] = 0.f;
#pragma unroll
    for (int q = 0; q < 4; ++q) o[q + 1] = o[q] + segtot[q * 128 + kk];
}
template <int MIX>
__device__ __forceinline__ void chunk_front(const Params& P, LAS unsigned char* lds, int n, int h, float (&loc)[16], float (&kv)[16], float (&o)[5]) {
    FrontC C; float zr[16]; f32x4 gq = (f32x4){0.f, 0.f, 0.f, 0.f};
    front_consts<MIX>(P, h, C);
    front_load<MIX>(P, n, h, zr, gq);
    front_compute<MIX>(lds, C, zr, gq, loc, kv, o);
}
template <int DV>
__device__ __forceinline__ void load_v(const bf16_t* vsrc, u32x4 (&vr)[DV / 64]) {
    const int tid = threadIdx.x;
#pragma unroll
    for (int r = 0; r < DV / 128; ++r) { const int idx = tid + 512 * r, s2 = idx & 31, c8 = idx >> 5;
        vr[2 * r] = *(const u32x4*)(vsrc + (size_t)(2 * s2) * LDZ1 + c8 * 8); vr[2 * r + 1] = *(const u32x4*)(vsrc + (size_t)(2 * s2 + 1) * LDZ1 + c8 * 8); }
}
template <int DV>
__device__ __forceinline__ void store_vt(const u32x4 (&vr)[DV / 64], LAS unsigned char* vt) {
    const int tid = threadIdx.x;
#pragma unroll
    for (int r = 0; r < DV / 128; ++r) {
        const int idx = tid + 512 * r, s2 = idx & 31, c8 = idx >> 5;
        const u32x4 a = vr[2 * r], b = vr[2 * r + 1];
#pragma unroll
        for (int e = 0; e < 4; ++e) {
            *(LAS unsigned*)(vt + (c8 * 8 + 2 * e) * 144 + s2 * 4) = (a[e] & 0xffffu) | (b[e] << 16);
            *(LAS unsigned*)(vt + (c8 * 8 + 2 * e + 1) * 144 + s2 * 4) = (a[e] >> 16) | (b[e] & 0xffff0000u);
        }
    }
}
template <int MIX>
__device__ __forceinline__ void scanA_unit(const Params& P, LAS unsigned char* lds, int n, int h, const FrontC& C, const float (&zr)[16], const f32x4& gq, const u32x4 (&vr)[(MIX ? 256 : 128) / 64]) {
    constexpr int DV = MIX ? 256 : 128, NH = MIX ? 4 : 8;
    const int tid = threadIdx.x, kk = tid & 127, i = tid >> 7, w = tid >> 6, lane = tid & 63, l15 = lane & 15, quad = lane >> 4;
    const bf16_t* Z = (const bf16_t*)(P.ws + WS_Z);
    bf16_t* ST = (bf16_t*)((unsigned char*)P.out + (MIX ? (size_t)SEQ * DM * 2 : 0)) + ((size_t)n * NH + h) * DV * 128;
    float* dbuf = (float*)(P.ws + WS_DBUF);
    constexpr int KD = 2048, VT = 2048 + 18432;
    float loc[16], kv[16], o[5];
    front_compute<MIX>(lds, C, zr, gq, loc, kv, o);
    { float e[16];
#pragma unroll
      for (int tt = 0; tt < 16; ++tt) e[tt] = kv[tt] * __expf(o[4] - o[i] - loc[tt]);
      u32x4 w0, w1; w0.x = cvt_pk_bf16(e[0], e[1]); w0.y = cvt_pk_bf16(e[2], e[3]); w0.z = cvt_pk_bf16(e[4], e[5]); w0.w = cvt_pk_bf16(e[6], e[7]);
      w1.x = cvt_pk_bf16(e[8], e[9]); w1.y = cvt_pk_bf16(e[10], e[11]); w1.z = cvt_pk_bf16(e[12], e[13]); w1.w = cvt_pk_bf16(e[14], e[15]);
      *(LAS u32x4*)(lds + KD + kk * 144 + i * 32) = w0; *(LAS u32x4*)(lds + KD + kk * 144 + i * 32 + 16) = w1; }
    if (i == 0) dbuf[(size_t)n * 1536 + (MIX ? 1024 : 0) + h * 128 + kk] = __expf(o[4]);
    store_vt<DV>(vr, lds + VT);
    __syncthreads();
    f32x4 acc[DV / 16];
#pragma unroll
    for (int nt = 0; nt < DV / 16; ++nt) acc[nt] = (f32x4){0.f, 0.f, 0.f, 0.f};
#pragma unroll
    for (int ks = 0; ks < 2; ++ks) {
        const bf16x8 af = *(const LAS bf16x8*)(lds + KD + (16 * w + l15) * 144 + (32 * ks + quad * 8) * 2);
#pragma unroll
        for (int nt = 0; nt < DV / 16; ++nt) { const bf16x8 bfv = *(const LAS bf16x8*)(lds + VT + (16 * nt + l15) * 144 + (32 * ks + quad * 8) * 2); acc[nt] = MFMA16(af, bfv, acc[nt]); }
    }
#pragma unroll
    for (int nt = 0; nt < DV / 16; ++nt) { u32x2 wv; wv.x = cvt_pk_bf16(acc[nt][0], acc[nt][1]); wv.y = cvt_pk_bf16(acc[nt][2], acc[nt][3]);
        *(u32x2*)(ST + (size_t)(16 * nt + l15) * 128 + 16 * w + quad * 4) = wv; }
    __syncthreads();
}
__device__ __forceinline__ void phase_scanB(const Params& P, LAS unsigned char* lds, int bid, int nb) {
    const float* dbuf = (const float*)(P.ws + WS_DBUF);
    LAS float* ld = (LAS float*)lds;
    const int tid = threadIdx.x;
    for (int e0 = bid * 512; e0 < 131072; e0 += nb * 512) {
        const int e = e0 + tid;
        const int mix = e >> 16, r = e & 65535;
        const int h = mix ? (r >> 14) : (r >> 13);
        const float* dsrc = dbuf + (mix ? 1024 : 0) + h * 128;
#pragma unroll 16
        for (int j = 0; j < 64; ++j) { const int idx = tid + 512 * j; ld[idx] = dsrc[(size_t)(idx >> 7) * 1536 + (idx & 127)]; }
        __syncthreads();
        unsigned* base = (unsigned*)((unsigned char*)P.out + (mix ? (size_t)SEQ * DM * 2 : 0)) + r;
        const int kp = (r & 63) * 2;
        float s0 = 0.f, s1 = 0.f;
#pragma unroll 32
        for (int n = 0; n < 256; ++n) {
            const unsigned uw = base[(size_t)n * 65536];
            const f32x2 d = *(const LAS f32x2*)(ld + n * 128 + kp);
            base[(size_t)n * 65536] = cvt_pk_bf16(s0, s1);
            s0 = d.x * s0 + __uint_as_float(uw << 16); s1 = d.y * s1 + __uint_as_float(uw & 0xffff0000u);
        }
        __syncthreads();
    }
}
template <int MIX>
__device__ __forceinline__ void scanC_unit(const Params& P, LAS unsigned char* lds, int n, int h, bool dummy) {
    constexpr int DV = MIX ? 256 : 128, NH = MIX ? 4 : 8, NTW = DV / 32;
    const int tid = threadIdx.x, kk = tid & 127, i = tid >> 7, w = __builtin_amdgcn_readfirstlane(tid >> 6), lane = tid & 63, l15 = lane & 15, quad = lane >> 4;
    bf16_t* Z = (bf16_t*)(P.ws + WS_Z);
    const bf16_t* ST = (const bf16_t*)((unsigned char*)P.out + (MIX ? (size_t)SEQ * DM * 2 : 0)) + ((size_t)n * NH + h) * DV * 128;
    constexpr int RS = 2048, QH = 2560, QT = 19968, KH0 = 37376, AB = 80896, VT = 90112;
    const int qcol = MIX ? 3072 + h * 128 : h * 128, vcol = MIX ? 6144 + h * 256 : 5120 + h * 128, gcol = MIX ? 4096 + h * 256 : 2048 + h * 128;
    const float* onorm = MIX ? P.onorm_d + h * 256 : P.onorm_c + h * 128;
    float loc[16], kv[16], o[5], qv[16];
    u32x4 vr[DV / 64];
#pragma unroll
    for (int tt = 0; tt < 16; ++tt) qv[tt] = bf2f(Z[(size_t)(64 * n + 16 * i + tt) * LDZ1 + qcol + kk]);
    load_v<DV>(Z + (size_t)(64 * n) * LDZ1 + vcol, vr);
    chunk_front<MIX>(P, lds, n, h, loc, kv, o);
    const int ip = w & 3, hv = w >> 2;
    bf16x8 sf[4][NTW]; u32x2 gwv[NTW];
    if (MIX == 0) {
#pragma unroll
        for (int ks = 0; ks < 4; ++ks)
#pragma unroll
            for (int nt = 0; nt < NTW; ++nt) sf[ks][nt] = *(const bf16x8*)(ST + (size_t)(16 * (hv * NTW + nt) + l15) * 128 + 32 * ks + quad * 8);
    }
#pragma unroll
    for (int nt = 0; nt < NTW; ++nt) gwv[nt] = *(const u32x2*)(Z + (size_t)(64 * n + 16 * ip + l15) * LDZ1 + gcol + 16 * (hv * NTW + nt) + quad * 4);
    const float scale = 0.08838834764831845f;
#ifndef CVAR
#define CVAR 0
#endif
    if (!(CVAR == 1 && dummy)) {
    { const float eo = __expf(o[i]);
#pragma unroll
      for (int tt = 0; tt < 16; ++tt) {
          const float q = qv[tt] * scale * __expf(loc[tt]);
          *(LAS bf16_t*)(lds + QH + (16 * i + tt) * 272 + kk * 2) = f2bf(q);
          *(LAS bf16_t*)(lds + QT + (16 * i + tt) * 272 + kk * 2) = f2bf(q * eo);
          kv[tt] *= __expf(-loc[tt]);
      } }
#pragma unroll
    for (int ip = 0; ip < 4; ++ip) {
        if (ip >= i) {
            const float fo = __expf(o[ip] - o[i]);
#pragma unroll
            for (int tt = 0; tt < 16; ++tt) *(LAS bf16_t*)(lds + KH0 + 4352 * (ip * (ip + 1) / 2) + (16 * i + tt) * 272 + kk * 2) = f2bf(kv[tt] * fo);
        }
    }
    }
    if (!(CVAR == 3 && dummy)) store_vt<DV>(vr, lds + VT);
    __syncthreads();
    if (MIX == 1) {
#pragma unroll
        for (int ks = 0; ks < 4; ++ks)
#pragma unroll
            for (int nt = 0; nt < NTW; ++nt) sf[ks][nt] = *(const bf16x8*)(ST + (size_t)(16 * (hv * NTW + nt) + l15) * 128 + 32 * ks + quad * 8);
    }
#pragma unroll
    for (int rep = 0; rep < 2; ++rep) {
        const int jb = w + 8 * rep;
        if (jb < 12) {
            int ipj, jt;
            if (jb >= 10) { ipj = (jb == 10) ? 0 : 2; jt = (jb == 10) ? 1 : 3; }
            else { ipj = jb >= 6 ? 3 : (jb >= 3 ? 2 : (jb >= 1 ? 1 : 0)); jt = jb - ipj * (ipj + 1) / 2; }
            f32x4 a = (f32x4){0.f, 0.f, 0.f, 0.f};
            if (jb < 10) {
                const int kho = KH0 + 4352 * (ipj * (ipj + 1) / 2);
#pragma unroll
                for (int ks = 0; ks < 4; ++ks) {
                    const bf16x8 qa = *(const LAS bf16x8*)(lds + QH + (16 * ipj + l15) * 272 + (32 * ks + quad * 8) * 2);
                    const bf16x8 kb = *(const LAS bf16x8*)(lds + kho + (16 * jt + l15) * 272 + (32 * ks + quad * 8) * 2);
                    a = MFMA16(qa, kb, a);
                }
                if (jt == ipj) {
#pragma unroll
                    for (int j = 0; j < 4; ++j) if (l15 > quad * 4 + j) a[j] = 0.f;
                }
            }
#pragma unroll
            for (int j = 0; j < 4; ++j) *(LAS bf16_t*)(lds + AB + (16 * ipj + quad * 4 + j) * 144 + (16 * jt + l15) * 2) = f2bf(a[j]);
        }
    }
    __syncthreads();
    f32x4 acc[NTW];
#pragma unroll
    for (int nt = 0; nt < NTW; ++nt) acc[nt] = (f32x4){0.f, 0.f, 0.f, 0.f};
#pragma unroll
    for (int ks = 0; ks < 4; ++ks) {
        const bf16x8 qa = *(const LAS bf16x8*)(lds + QT + (16 * ip + l15) * 272 + (32 * ks + quad * 8) * 2);
#pragma unroll
        for (int nt = 0; nt < NTW; ++nt) acc[nt] = MFMA16(sf[ks][nt], qa, acc[nt]);
    }
#pragma unroll
    for (int ks = 0; ks < 2; ++ks) {
        if (ks == 0 || ip >= 2) {
            const bf16x8 aa = *(const LAS bf16x8*)(lds + AB + (16 * ip + l15) * 144 + (32 * ks + quad * 8) * 2);
#pragma unroll
            for (int nt = 0; nt < NTW; ++nt) { const bf16x8 vb = *(const LAS bf16x8*)(lds + VT + (16 * (hv * NTW + nt) + l15) * 144 + (32 * ks + quad * 8) * 2); acc[nt] = MFMA16(vb, aa, acc[nt]); }
        }
    }
    LAS float* rowss = (LAS float*)(lds + RS);
    { float ss = 0.f;
#pragma unroll
      for (int nt = 0; nt < NTW; ++nt) ss += acc[nt][0] * acc[nt][0] + acc[nt][1] * acc[nt][1] + acc[nt][2] * acc[nt][2] + acc[nt][3] * acc[nt][3];
      ss += __shfl_xor(ss, 16); ss += __shfl_xor(ss, 32);
      if (quad == 0) rowss[hv * 64 + 16 * ip + l15] = ss; }
    __syncthreads();
    { const float tot = rowss[16 * ip + l15] + rowss[64 + 16 * ip + l15];
      const float rinv = rsqrtf(tot * (1.0f / DV) + 1e-6f);
      const size_t row = (size_t)(64 * n + 16 * ip + l15);
#pragma unroll
      for (int nt = 0; nt < NTW; ++nt) {
          const int vv0 = 16 * (hv * NTW + nt) + quad * 4;
          const u32x2 gw = gwv[nt];
          const f32x4 on = *(const f32x4*)(onorm + vv0);
          const float o0 = acc[nt][0] * rinv * on[0] * __uint_as_float(gw.x << 16), o1 = acc[nt][1] * rinv * on[1] * __uint_as_float(gw.x & 0xffff0000u);
          const float o2 = acc[nt][2] * rinv * on[2] * __uint_as_float(gw.y << 16), o3 = acc[nt][3] * rinv * on[3] * __uint_as_float(gw.y & 0xffff0000u);
          u32x2 yw; yw.x = cvt_pk_bf16(o0, o1); yw.y = cvt_pk_bf16(o2, o3);
          if (!dummy || o0 == 12345.678f) *(u32x2*)(Z + row * LDZ1 + vcol + vv0) = yw;
      } }
    __syncthreads();
}
template <int MIX>
__device__ __forceinline__ void scanA_loop(const Params& P, LAS unsigned char* lds, int bid, int nb) {
    constexpr int DV = MIX ? 256 : 128, NH = MIX ? 4 : 8, NU = 256 * NH;
    if (bid >= NU) return;
    const bf16_t* Z = (const bf16_t*)(P.ws + WS_Z);
    int hc = bid % NH;
    FrontC C; front_consts<MIX>(P, hc, C);
    float zn[16]; f32x4 gn = (f32x4){0.f, 0.f, 0.f, 0.f}; u32x4 vn[DV / 64];
    { const int n = bid / NH, h = bid % NH; front_load<MIX>(P, n, h, zn, gn); load_v<DV>(Z + (size_t)(64 * n) * LDZ1 + (MIX ? 6144 + h * 256 : 5120 + h * 128), vn); }
    for (int u = bid; u < NU; u += nb) {
        const int n = u / NH, h = u % NH;
        float zr[16]; u32x4 vr[DV / 64]; const f32x4 gq = gn;
#pragma unroll
        for (int t = 0; t < 16; ++t) zr[t] = zn[t];
#pragma unroll
        for (int t = 0; t < DV / 64; ++t) vr[t] = vn[t];
        const int un = u + nb;
        if (un < NU) { const int n2 = un / NH, h2 = un % NH; front_load<MIX>(P, n2, h2, zn, gn); load_v<DV>(Z + (size_t)(64 * n2) * LDZ1 + (MIX ? 6144 + h2 * 256 : 5120 + h2 * 128), vn); }
        if (h != hc) { hc = h; front_consts<MIX>(P, h, C); }
        scanA_unit<MIX>(P, lds, n, h, C, zr, gq, vr);
    }
}
__device__ __forceinline__ void phase_scanA(const Params& P, LAS unsigned char* lds, int bid, int nb) {
    scanA_loop<0>(P, lds, bid, nb);
    scanA_loop<1>(P, lds, bid, nb);
}
__device__ __forceinline__ void phase_scanC(const Params& P, LAS unsigned char* lds, int bid, int nb, bool dummy) {
    for (int u = bid; u < 3072; u += nb) { const int n = u / 12, hh = u % 12; if (hh < 8) scanC_unit<0>(P, lds, n, hh, dummy); else scanC_unit<1>(P, lds, n, hh - 8, dummy); }
}
__device__ __forceinline__ void phase_final(const Params& P, int bid, int nb) {
    const int tid = threadIdx.x, wid = tid >> 6, lane = tid & 63;
    const float* ss4 = (const float*)(P.ws + WS_STAT) + 7 * SEQ;
    const bf16_t* hb = (const bf16_t*)(P.ws + WS_HA);
    f32x4 g0[4], g1[4];
#pragma unroll
    for (int i = 0; i < 4; ++i) { const int c = lane * 8 + 512 * i; g0[i] = *(const f32x4*)(P.final_norm + c); g1[i] = *(const f32x4*)(P.final_norm + c + 4); }
    for (int row = bid * 32 + wid * 4; row < SEQ; row += nb * 32) {
        u32x4 hw[4][4]; float rinv[4];
#pragma unroll
        for (int q = 0; q < 4; ++q) {
            rinv[q] = ss4[row + q];
#pragma unroll
            for (int i = 0; i < 4; ++i) hw[q][i] = *(const u32x4*)(hb + (size_t)(row + q) * DM + lane * 8 + 512 * i);
        }
#pragma unroll
        for (int q = 0; q < 4; ++q) {
            const float ri = rsqrtf(rinv[q] * (1.f / 2048.f) + 1e-6f);
            float* orow = P.out + (size_t)(row + q) * DM;
#pragma unroll
            for (int i = 0; i < 4; ++i) {
                const int c = lane * 8 + 512 * i; const u32x4 w = hw[q][i];
                f32x4 o0, o1;
                o0[0] = __uint_as_float(w[0] << 16) * ri * g0[i][0]; o0[1] = __uint_as_float(w[0] & 0xffff0000u) * ri * g0[i][1];
                o0[2] = __uint_as_float(w[1] << 16) * ri * g0[i][2]; o0[3] = __uint_as_float(w[1] & 0xffff0000u) * ri * g0[i][3];
                o1[0] = __uint_as_float(w[2] << 16) * ri * g1[i][0]; o1[1] = __uint_as_float(w[2] & 0xffff0000u) * ri * g1[i][1];
                o1[2] = __uint_as_float(w[3] << 16) * ri * g1[i][2]; o1[3] = __uint_as_float(w[3] & 0xffff0000u) * ri * g1[i][3];
                *(f32x4*)(orow + c) = o0; *(f32x4*)(orow + c + 4) = o1;
            }
        }
    }
}

__device__ __forceinline__ void phase_glr(const Params& P, LAS unsigned char* lds, int bid, int nb) {
    const int tid = threadIdx.x, w = __builtin_amdgcn_readfirstlane(tid >> 6), lane = tid & 63, l15 = lane & 15, quad = lane >> 4;
    const bf16_t* A = (const bf16_t*)(P.ws + WS_HA);
    const bf16_t* Wt = (const bf16_t*)(P.ws + WS_WIN1) + (size_t)7168 * DM;
    const float* ss2 = (const float*)(P.ws + WS_STAT) + 4 * SEQ;
    float* glr = (float*)(P.ws + WS_GLR);
    LAS f32x4* part = (LAS f32x4*)lds;
    for (int g = bid; g < SEQ / 64; g += nb) {
        const int blk = w & 3, kh = w >> 2, r0 = 64 * g + 16 * blk;
        const bf16_t* ap = A + (size_t)(r0 + l15) * DM + kh * 1024 + quad * 8;
        const bf16_t* bp = Wt + (size_t)l15 * DM + kh * 1024 + quad * 8;
        f32x4 acc = (f32x4){0.f, 0.f, 0.f, 0.f};
#pragma unroll 8
        for (int ks = 0; ks < 32; ++ks) { const bf16x8 av = *(const bf16x8*)(ap + 32 * ks), bv = *(const bf16x8*)(bp + 32 * ks); acc = MFMA16(bv, av, acc); }
        if (kh == 1) part[blk * 64 + lane] = acc;
        __syncthreads();
        if (kh == 0) {
            const f32x4 o = acc + part[blk * 64 + lane];
            const float rs = rsqrtf(ss2[r0 + l15] * (1.f / 2048.f) + 1e-6f);
            *(f32x4*)(glr + (size_t)(r0 + l15) * 16 + quad * 4) = o * rs;
        }
        __syncthreads();
    }
}

template <int MODE>
__device__ __forceinline__ void run_gemm(LAS unsigned char* lds, const bf16_t* A, int lda, const bf16_t* Bt, int N, int K, const Epi<MODE>& E, int G, int c) {
    pg8::Gemm g; g.A = A; g.Bt = Bt; g.lda = lda; g.M = SEQ; g.N = N; g.K = K;
    pg8::StaticOrder S; S.init(SEQ, N, G, c);
    pg8::gemm_phase<Epi<MODE>>(lds, g, S, E);
}

#define XB_TMO      128
#define XB_XCNT(j)  (256  + 64 * (j))
#define XB_XSUB(j)  (1280 + 64 * (j))
#define XB_XGEN(j)  (2304 + 64 * (j))
#define XB_TOP      3328
#define XB_TOPGEN   3392
#define XCD_BAR_WORDS 3456
#define XB_SPIN_CAP (1u << 18)

__device__ __forceinline__ unsigned xb_ld(unsigned* p)              { return __hip_atomic_load(p, __ATOMIC_RELAXED, __HIP_MEMORY_SCOPE_AGENT); }
__device__ __forceinline__ unsigned xb_add(unsigned* p, unsigned v) { return __hip_atomic_fetch_add(p, v, __ATOMIC_RELAXED, __HIP_MEMORY_SCOPE_AGENT); }
__device__ __forceinline__ unsigned xb_xcc_id() { return (unsigned)__builtin_amdgcn_s_getreg((3 << 11) | 20) & 0xFu; }
#define XB_SPIN(cond, bar) do { unsigned _sp = 0; while (cond) { __builtin_amdgcn_s_sleep(1); \
    if ((++_sp & 255u) == 0u) { if (xb_ld(&(bar)[XB_TMO])) break; if (_sp > XB_SPIN_CAP) { atomicAdd(&(bar)[XB_TMO], 1u); break; } } } } while (0)

struct XcdBarrier {
    unsigned* bar; unsigned x;
    volatile LAS unsigned* st;
};

__device__ __forceinline__ XcdBarrier xcd_barrier_post(unsigned* bar, volatile LAS unsigned* st) {
    XcdBarrier b; b.bar = bar; b.x = xb_xcc_id(); b.st = st;
    if (threadIdx.x == 0) (void)xb_add(&bar[XB_XCNT(b.x)], 1u);
    return b;
}
__device__ __forceinline__ void xcd_barrier_complete(unsigned* bar, unsigned x, unsigned& nloc, unsigned& nx) {
    const unsigned G = gridDim.x * gridDim.y * gridDim.z;
    unsigned sum, cnt, mine, sp = 0u;
    for (;;) {
        sum = 0u; cnt = 0u; mine = 0u;
#pragma unroll
        for (unsigned j = 0; j < 16; ++j) { const unsigned c = xb_ld(&bar[XB_XCNT(j)]); sum += c; cnt += (c > 0u) ? 1u : 0u; mine = (j == x) ? c : mine; }
        if (sum == G) break;
        __builtin_amdgcn_s_sleep(1);
        if ((++sp & 255u) == 0u) { if (xb_ld(&bar[XB_TMO])) break; if (sp > XB_SPIN_CAP) { atomicAdd(&bar[XB_TMO], 1u); break; } }
    }
    nloc = mine > 0u ? mine : 1u; nx = cnt > 0u ? cnt : 1u;
}

__device__ __forceinline__ void xcd_barrier(const XcdBarrier& b) {
    asm volatile("s_waitcnt vmcnt(0)" ::: "memory");
    __syncthreads();
    if (threadIdx.x == 0) {
        unsigned* bar = b.bar;
        __builtin_amdgcn_s_waitcnt(0);
        unsigned nloc = b.st[0], nx = b.st[1];
        if (nloc == 0u) { xcd_barrier_complete(bar, b.x, nloc, nx); b.st[0] = nloc; b.st[1] = nx; }
        const unsigned old = xb_add(&bar[XB_XSUB(b.x)], 1u);
        const unsigned gen = old / nloc;
        if (old + 1u == (gen + 1u) * nloc) {
            __builtin_amdgcn_fence(__ATOMIC_RELEASE, "agent");
            asm volatile("s_waitcnt vmcnt(0)" ::: "memory");
            const unsigned og = xb_add(&bar[XB_TOP], 1u);
            const unsigned tg = og / nx;
            if (og + 1u == (tg + 1u) * nx) xb_add(&bar[XB_TOPGEN], 1u);
            else XB_SPIN(xb_ld(&bar[XB_TOPGEN]) == tg, bar);
            __builtin_amdgcn_fence(__ATOMIC_ACQUIRE, "agent");
            xb_add(&bar[XB_XGEN(b.x)], 1u);
            asm volatile("s_waitcnt vmcnt(0)" ::: "memory");
        } else {
            XB_SPIN(xb_ld(&bar[XB_XGEN(b.x)]) == gen, bar);
            __builtin_amdgcn_fence(__ATOMIC_ACQUIRE, "agent");
            asm volatile("s_waitcnt vmcnt(0)" ::: "memory");
        }
    }
    __syncthreads();
}


__device__ __forceinline__ void grid_bar(unsigned* ctr, unsigned target) {
    asm volatile("s_waitcnt vmcnt(0)" ::: "memory");
    __syncthreads();
    if (threadIdx.x == 0) {
        __builtin_amdgcn_fence(__ATOMIC_RELEASE, "agent");
        asm volatile("s_waitcnt vmcnt(0)" ::: "memory");
        __hip_atomic_fetch_add(ctr, 1u, __ATOMIC_RELAXED, __HIP_MEMORY_SCOPE_AGENT);
        while (__hip_atomic_load(ctr, __ATOMIC_RELAXED, __HIP_MEMORY_SCOPE_AGENT) < target) __builtin_amdgcn_s_sleep(2);
        __builtin_amdgcn_fence(__ATOMIC_ACQUIRE, "agent");
        asm volatile("s_waitcnt vmcnt(0)" ::: "memory");
    }
    __syncthreads();
}
__device__ __forceinline__ bool phase_begin(const Params& P, int k, const XcdBarrier& xb) {
    if (k < P.ph_lo || k >= P.ph_hi) return false;
    if (k > P.ph_lo) {
        if (P.ph_hi < 0) cg::this_grid().sync();
        xcd_barrier(xb);
    }
    return true;
}
template <int K>
__device__ __forceinline__ void run_phase(const Params& P, LAS unsigned char* lds, int bid, int nb, bool dummy) {
    unsigned char* ws = P.ws;
    float* stat = (float*)(ws + WS_STAT);
    float *ss0 = stat, *ssv = stat + SEQ, *ssE0 = stat + 2 * SEQ, *ss1 = stat + 3 * SEQ, *ss2 = stat + 4 * SEQ, *ss3 = stat + 5 * SEQ, *ssE1 = stat + 6 * SEQ, *ss4 = stat + 7 * SEQ, *ssD = stat + 8 * SEQ;
    bf16_t *HA = (bf16_t*)(ws + WS_HA), *HB = (bf16_t*)(ws + WS_HB), *Z = (bf16_t*)(ws + WS_Z), *E0 = (bf16_t*)(ws + WS_E0), *PBF = (bf16_t*)(ws + WS_PB);
    if (K == 0) phase_prep(P, lds, bid, nb);
    if (K == 1) {
        { Epi<1> E{}; E.o16 = Z; E.ld16 = LDZ0; E.ss_in = ss0; E.ss_out = dummy ? ssD : ssv; run_gemm<1>(lds, HA, DM, (const bf16_t*)(ws + WS_WIN0), 5376, 2048, E, nb, bid); }
        { const int skip = (nb == 256) ? 64 : 0;
          if (bid >= skip && !(DUP_PH == 101 && dummy)) { Epi<2> E{}; E.o16 = E0; E.ld16 = DM; E.ss_out = dummy ? ssD : ssE0; run_gemm<2>(lds, PBF, 256, (const bf16_t*)(ws + WS_WP0), 2048, 256, E, nb - skip, bid - skip);
            if (!dummy) phase_wconv(P, lds, 32 * 21 + 256 + 256 + 32, 32 * 21 + 256 + 256 + 32 + 32 * 29 + 256 + 256 + 32, bid - skip, nb - skip); } }
    }
    if (K == 2) phase_mix0(P, lds, bid, nb);
    if (K == 3) { Epi<3> E{}; E.o16 = HB; E.ld16 = DM; E.resid = P.x; E.ss_out = dummy ? ssD : ss1; run_gemm<3>(lds, HA, DM, (const bf16_t*)(ws + WS_WOUT0), 2048, 2048, E, nb, bid); }
    if (K == 4) { Epi<4> E{}; E.o16 = HA; E.ld16 = DM; E.resid16 = HB; E.ss_in = ss1; E.ss_out = ss2; E.E = E0; E.ssE = ssE0; E.pnorm = P.ple_norm; E.dummy = dummy; if (dummy) E.ss_out = ssD;
        run_gemm<4>(lds, HB, DM, (const bf16_t*)(ws + WS_WG0), 2048, 2048, E, nb, bid); }
    if (K == 5) { Epi<5> E{}; E.o16 = Z; E.ld16 = LDZ1; E.ss_in = ss2; E.glr = (float*)(ws + WS_GLR); E.dummy = (DUP_PH == 105) ? dummy : 0; run_gemm<5>(lds, HA, DM, (const bf16_t*)(ws + WS_WIN1), 7168, 2048, E, nb, bid); if (!(DUP_PH == 105 && dummy)) phase_glr(P, lds, bid, nb); }
    if (K == 6) phase_scanA(P, lds, bid, nb);
    if (K == 7) phase_scanB(P, lds, bid, nb);
    if (K == 8) phase_scanC(P, lds, bid, nb, dummy);
    if (K == 9) {
        { Epi<3> E{}; E.o16 = HB; E.ld16 = DM; E.resid16 = HA; E.ss_out = ss3; run_gemm<3>(lds, Z + 5120, LDZ1, (const bf16_t*)(ws + WS_WOUT1), 2048, 2048, E, nb, bid); }
        { Epi<2> E{}; E.o16 = (bf16_t*)P.out; E.ld16 = DM; E.ss_out = ssE1; run_gemm<2>(lds, PBF + (size_t)SEQ * 256, 256, (const bf16_t*)(ws + WS_WP1), 2048, 256, E, nb, bid); }
    }
    if (K == 10) { Epi<4> E{}; E.o16 = HA; E.ld16 = DM; E.resid16 = HB; E.ss_in = ss3; E.ss_out = ss4; E.E = (const bf16_t*)P.out; E.ssE = ssE1; E.pnorm = P.ple_norm + DM; E.dummy = dummy; if (dummy) E.ss_out = ssD;
        run_gemm<4>(lds, HB, DM, (const bf16_t*)(ws + WS_WG1), 2048, 2048, E, nb, bid); }
    if (K == 11) phase_final(P, bid, nb);
}
#define PHASE(k) do { if ((ONLY_PH < 0 || ONLY_PH == (k)) && phase_begin(P, (k), xb)) { \
        if (DUP_PH == (k) || (DUP_PH == 101 && (k) == 1) || (DUP_PH == 105 && (k) == 5)) { run_phase<(k)>(P, lds, bid, nb, true); cg::this_grid().sync(); } \
        run_phase<(k)>(P, lds, bid, nb, false); \
        if (DUP_PH == 67 && (k) == 7) { cg::this_grid().sync(); run_phase<6>(P, lds, bid, nb, false); cg::this_grid().sync(); run_phase<7>(P, lds, bid, nb, false); } \
        if (DUP_PH == 5678 && (k) == 8) { cg::this_grid().sync(); run_phase<5>(P, lds, bid, nb, false); cg::this_grid().sync(); run_phase<6>(P, lds, bid, nb, false); cg::this_grid().sync(); run_phase<7>(P, lds, bid, nb, false); cg::this_grid().sync(); run_phase<8>(P, lds, bid, nb, false); } \
        } } while (0)
__global__ void __launch_bounds__(512, 2) mega(Params P) {
    extern __shared__ __attribute__((aligned(16))) unsigned char shm[];
    LAS unsigned char* lds = (LAS unsigned char*)shm;
    const int bid = blockIdx.x, nb = gridDim.x;
    volatile LAS unsigned* xst = (volatile LAS unsigned*)(lds + 131072);
    if (threadIdx.x == 0) { xst[0] = 0u; xst[1] = 0u; }
    __syncthreads();
    XcdBarrier xb = xcd_barrier_post((unsigned*)(P.ws + WS_BAR), xst);
    PHASE(0); PHASE(1);
#if DUP_PH == 100
    for (int q = 0; q < 20; ++q) grid_bar((unsigned*)(P.ws + WS_BAR) + 32, (unsigned)(q + 1) * gridDim.x);
#endif
 PHASE(2); PHASE(3); PHASE(4); PHASE(5); PHASE(6); PHASE(7); PHASE(8); PHASE(9); PHASE(10); PHASE(11);
}

extern "C" void kernel_launch(void* const* d_in, const int* in_sizes, int n_in, void* d_out, int out_size, void* d_ws, size_t ws_size, hipStream_t stream) {
    static int grid = 0;
    if (grid == 0) {
        if (n_in != 21 || out_size != SEQ * DM || ws_size < WS_END) { fprintf(stderr, "kernel_launch: unexpected shapes (n_in %d out %d ws %zu need %zu)\n", n_in, out_size, ws_size, (size_t)WS_END); grid = -1; return; }
        int dev = 0, cus = 0, per_cu = 0;
        hipGetDevice(&dev);
        hipDeviceGetAttribute(&cus, hipDeviceAttributeMultiprocessorCount, dev);
        if (hipFuncSetAttribute((const void*)mega, hipFuncAttributeMaxDynamicSharedMemorySize, LDS_BYTES) != hipSuccess) { fprintf(stderr, "kernel_launch: hipFuncSetAttribute failed\n"); grid = -1; return; }
        if (hipOccupancyMaxActiveBlocksPerMultiprocessor(&per_cu, (const void*)mega, 512, LDS_BYTES) != hipSuccess || per_cu < 1) { fprintf(stderr, "kernel_launch: occupancy query says %d\n", per_cu); per_cu = 1; }
        (void)hipGetLastError();
        grid = cus * 1;
    }
    if (grid < 0) return;
    Params P{};
    const float** pp = (const float**)&P;
    for (int i = 0; i < 21; ++i) pp[i] = (const float*)d_in[i];
    P.out = (float*)d_out; P.ws = (unsigned char*)d_ws;
#if ONE_LAUNCH
    P.ph_lo = 0; P.ph_hi = NPH;
    if (hipMemsetAsync((unsigned char*)d_ws + WS_BAR, 0, 16384, stream) != hipSuccess) { fprintf(stderr, "kernel_launch: memset of barrier words failed\n"); return; }
    void* args[] = {&P};
    hipError_t e = hipLaunchCooperativeKernel((const void*)mega, dim3(grid), dim3(512), args, LDS_BYTES, stream);
    if (e != hipSuccess) fprintf(stderr, "cooperative launch failed: %s (grid %d)\n", hipGetErrorString(e), grid);
#else
    for (int ph = 0; ph < NPH; ++ph) { P.ph_lo = ph; P.ph_hi = ph + 1; hipLaunchKernelGGL(mega, dim3(grid), dim3(512), LDS_BYTES, stream, P); }
#endif
}
```

```cpp
#include <hip/hip_runtime.h>
#include <hip/hip_cooperative_groups.h>
#include <cstdio>
namespace cg = cooperative_groups;

#ifndef ONE_LAUNCH
#define ONE_LAUNCH 1
#endif

#ifndef DUP_PH
#define DUP_PH -1
#endif
#ifndef ONLY_PH
#define ONLY_PH -1
#endif
#define LAS __attribute__((address_space(3)))
typedef unsigned short bf16_t;
typedef short bf16x8 __attribute__((ext_vector_type(8)));
typedef float f32x4 __attribute__((ext_vector_type(4)));
typedef float f32x2 __attribute__((ext_vector_type(2)));
typedef unsigned u32x4 __attribute__((ext_vector_type(4)));
typedef unsigned u32x2 __attribute__((ext_vector_type(2)));

constexpr int SEQ = 16384, DM = 2048;
constexpr int LDZ0 = 5376, LDZ1 = 7424;
constexpr int NPH = 12;
constexpr int LDS_BYTES = 131072 + 16;

constexpr size_t SZ_WIN0 = (size_t)5376 * 2048 * 2, SZ_W2K = (size_t)2048 * 2048 * 2, SZ_WP = (size_t)2048 * 256 * 2, SZ_WIN1 = (size_t)7424 * 2048 * 2;
constexpr size_t WS_WIN0 = 0, WS_WOUT0 = WS_WIN0 + SZ_WIN0, WS_WG0 = WS_WOUT0 + SZ_W2K, WS_WP0 = WS_WG0 + SZ_W2K;
constexpr size_t WS_WIN1 = WS_WP0 + SZ_WP, WS_WOUT1 = WS_WIN1 + SZ_WIN1, WS_WG1 = WS_WOUT1 + SZ_W2K, WS_WP1 = WS_WG1 + SZ_W2K;
constexpr size_t WS_PB = WS_WP1 + SZ_WP;
constexpr size_t WS_HA = WS_PB + (size_t)2 * SEQ * 256 * 2;
constexpr size_t WS_HB = WS_HA + (size_t)SEQ * DM * 2;
constexpr size_t WS_Z = WS_HB + (size_t)SEQ * DM * 2;
constexpr size_t WS_E0 = WS_Z + (size_t)SEQ * LDZ0 * 2;
constexpr size_t WS_STAT = WS_Z + (size_t)SEQ * LDZ1 * 2;
constexpr size_t WS_GLR = WS_STAT + (size_t)9 * SEQ * 4;
constexpr size_t WS_DBUF = WS_GLR + (size_t)SEQ * 16 * 4;
constexpr size_t WS_BAR = WS_DBUF + (size_t)256 * 1536 * 4;
constexpr size_t WS_END = WS_BAR + 16384;

struct Params {
    const float *x, *p, *norm_mix, *w_in_even, *sinks, *vnorm, *w_sp, *b_sp, *w_out_even, *w_in_odd, *lower_bounds, *onorm_c, *w_gate_up, *b_gate, *onorm_d,
        *w_out_odd, *w_ple_proj, *ple_norm, *ple_gate_norm, *w_ple_gate, *final_norm;
    float* out; unsigned char* ws; int ph_lo, ph_hi;
};

__device__ __forceinline__ float bf2f(bf16_t b) { return __uint_as_float(((unsigned)b) << 16); }
typedef __bf16 bf16v2_t __attribute__((ext_vector_type(2)));
__device__ __forceinline__ unsigned cvt_pk_bf16(float lo, float hi) { const f32x2 v = (f32x2){lo, hi}; const bf16v2_t r = __builtin_convertvector(v, bf16v2_t); return __builtin_bit_cast(unsigned, r); }
__device__ __forceinline__ bf16_t f2bf(float f) { return (bf16_t)(cvt_pk_bf16(f, 0.f) & 0xffffu); }
__device__ __forceinline__ float fast_sigmoid(float x) { return __builtin_amdgcn_rcpf(1.0f + __builtin_amdgcn_exp2f(-1.44269504f * x)); }
__device__ __forceinline__ float silu_f(float x) { return x * fast_sigmoid(x); }
__device__ __forceinline__ f32x2 gelu_pk(f32x2 v) {
    const f32x2 av = __builtin_elementwise_abs(v), d = av * 0.2316418882f + 1.0f;
    f32x2 t; t.x = __builtin_amdgcn_rcpf(d.x); t.y = __builtin_amdgcn_rcpf(d.y);
    f32x2 q = t * 0.5307027145f + (-0.7265760135f); q = q * t + 0.7107068705f; q = q * t + (-0.142248368f); q = q * t + 0.127414796f; q = q * t;
    const f32x2 s = (v * v) * (-0.72134752044f);
    f32x2 e; e.x = __builtin_amdgcn_exp2f(s.x); e.y = __builtin_amdgcn_exp2f(s.y);
    const f32x2 m = v * (q * e), r = v - m;
    f32x2 o; o.x = v.x < 0.f ? m.x : r.x; o.y = v.y < 0.f ? m.y : r.y; return o;
}
#define MFMA16(a, b, c) __builtin_amdgcn_mfma_f32_16x16x32_bf16((a), (b), (c), 0, 0, 0)

namespace pg8 {
constexpr int BM = 256, BK = 64, HALF = 128, HTB = HALF * BK * 2, NXCD = 8, WGM = 8;
__host__ __device__ __forceinline__ int lds_byte(int r, int c) { const int st = (r >> 4) * 2 + (c >> 5), rr = r & 15, cc = c & 31, ob = rr * 64 + cc * 2; return st * 1024 + (ob ^ (((ob >> 9) & 1) << 5)); }
__host__ __device__ __forceinline__ void stage_rc(int b, int& R, int& C) { const int st = b / 1024, sb = b % 1024, swz = sb ^ (((sb >> 9) & 1) << 5); R = (st >> 1) * 16 + swz / 64; C = (st & 1) * 32 + (swz % 64) / 2; }
__host__ __device__ __forceinline__ int perm32(int rho) { const int n = rho >> 4, i = rho & 15; return 8 * (i >> 2) + 4 * n + (i & 3); }
struct Unit { int pm, pn; };
struct Gemm { const bf16_t* A; const bf16_t* Bt; int lda, M, N, K; };
struct StaticOrder {
    int nM, nN, nwg, G, c;
    __device__ void init(int M, int N, int G_, int c_) { nM = M / BM; nN = N / BM; nwg = nM * nN; G = G_; c = c_; }
    __device__ bool next(int i, Unit& u) const {
        const long L = (long)i * G + c; if (L >= nwg) return false;
        int wgid = (int)L; { const int q = nwg / NXCD, r = nwg % NXCD, xcd = wgid % NXCD, off = wgid / NXCD; wgid = (xcd < r ? xcd * (q + 1) : r * (q + 1) + (xcd - r) * q) + off; }
        const int nig = WGM * nN, gid = wgid / nig, fm = gid * WGM, gsz = (nM - fm) < WGM ? (nM - fm) : WGM;
        u.pm = fm + ((wgid % nig) % gsz); u.pn = (wgid % nig) / gsz; return true;
    }
};

template <class Epi>
__device__ __forceinline__ void gemm_phase(LAS unsigned char* lds, const Gemm g, const StaticOrder& S, const Epi& E) {
    const int tid = threadIdx.x, wid = __builtin_amdgcn_readfirstlane(tid >> 6), lane = tid & 63, wr = wid >> 2, wc = wid & 3, fr = lane & 15, fq = lane >> 4;
    int K = g.K; asm volatile("" : "+s"(K)); const int nt = K / BK, lda = g.lda;
    unsigned voffA[2], voffB[2];
#pragma unroll
    for (int i = 0; i < 2; ++i) { int R, C; stage_rc(tid * 16 + i * 8192, R, C); const int Rb = Epi::PERM ? ((R & ~31) + perm32(R & 31)) : R;
        voffA[i] = (unsigned)(R * lda + C) * 2u; voffB[i] = (unsigned)(Rb * K + C) * 2u; }
    const size_t kstep = (size_t)(BK * 2);
    const size_t hstepA = (size_t)HALF * lda * 2, hstepB = (size_t)HALF * K * 2;
    const size_t tstepA = 2 * hstepA, tstepB = 2 * hstepB;
    const unsigned ldsw = (unsigned)wid * 1024u;
    const int aoff = lds_byte(wr * 64 + fr, fq * 8), boff = lds_byte(wc * 32 + fr, fq * 8);
#define PG8_SA(b, h) (((b) * 2 + (h)) * HTB)
#define PG8_SB(b, h) ((4 + (b) * 2 + (h)) * HTB)
#define PG8_STAGE(bufoff, gbase, voff) do { _Pragma("unroll") for (int _i = 0; _i < 2; ++_i) \
        __builtin_amdgcn_global_load_lds((const unsigned*)((const char*)(gbase) + (voff)[_i]), (LAS unsigned*)(lds + (bufoff) + ldsw + _i * 8192), 16, 0, 0); } while (0)
#define PG8_LDA(dst, b, h) do { _Pragma("unroll") for (int m = 0; m < 4; ++m) _Pragma("unroll") for (int k = 0; k < 2; ++k) dst[m][k] = *(const LAS bf16x8*)(lds + PG8_SA(b, h) + aoff + m * 2048 + k * 1024); } while (0)
#define PG8_LDB(dst, b, h) do { _Pragma("unroll") for (int n = 0; n < 2; ++n) _Pragma("unroll") for (int k = 0; k < 2; ++k) dst[n][k] = *(const LAS bf16x8*)(lds + PG8_SB(b, h) + boff + n * 2048 + k * 1024); } while (0)
#define PG8_MMA(ai, bj, At, Bt) do { __builtin_amdgcn_s_setprio(1); _Pragma("unroll") for (int m = 0; m < 4; ++m) _Pragma("unroll") for (int n = 0; n < 2; ++n) _Pragma("unroll") for (int k = 0; k < 2; ++k) \
        acc[ai][bj][m][n] = __builtin_amdgcn_mfma_f32_16x16x32_bf16(Bt[n][k], At[m][k], acc[ai][bj][m][n], 0, 0, 0); __builtin_amdgcn_s_setprio(0); } while (0)
#define PG8_WAIT_V(n) asm volatile("s_waitcnt vmcnt(" #n ")" ::: "memory")
#define PG8_WAIT_L(n) asm volatile("s_waitcnt lgkmcnt(" #n ")" ::: "memory")
#define PG8_BAR __builtin_amdgcn_s_barrier()
#define PG8_SCHED __builtin_amdgcn_sched_barrier(0)
    Unit cur, nxt, pu; int ui = 0;
    if (!S.next(0, cur)) return;
    pu = cur; float psum[8] = {0.f, 0.f, 0.f, 0.f, 0.f, 0.f, 0.f, 0.f}; bool pend = false;
    f32x4 acc[2][2][4][2];
#pragma unroll
    for (int a = 0; a < 2; ++a)
#pragma unroll
        for (int b = 0; b < 2; ++b)
#pragma unroll
            for (int m = 0; m < 4; ++m)
#pragma unroll
                for (int n = 0; n < 2; ++n) acc[a][b][m][n] = (f32x4){0.f, 0.f, 0.f, 0.f};
    bf16x8 At[4][2], B0[2][2], B1[2][2];
    const char* cA = (const char*)g.A + (size_t)cur.pm * tstepA; const char* cB = (const char*)g.Bt + (size_t)cur.pn * tstepB;
    PG8_STAGE(PG8_SB(0, 0), cB, voffB); PG8_STAGE(PG8_SA(0, 0), cA, voffA); PG8_STAGE(PG8_SB(0, 1), cB + hstepB, voffB); PG8_STAGE(PG8_SA(0, 1), cA + hstepA, voffA);
    if (wr == 1) PG8_BAR;
    PG8_WAIT_V(4); PG8_BAR;
    PG8_STAGE(PG8_SB(1, 0), cB + kstep, voffB); PG8_STAGE(PG8_SA(1, 0), cA + kstep, voffA); PG8_STAGE(PG8_SB(1, 1), cB + hstepB + kstep, voffB);
    PG8_WAIT_V(6); PG8_BAR;
    for (;;) {
        const bool has_next = S.next(ui + 1, nxt);
        const char* nA = has_next ? (const char*)g.A + (size_t)nxt.pm * tstepA : cA; const char* nB = has_next ? (const char*)g.Bt + (size_t)nxt.pn * tstepB : cB;
#pragma clang loop unroll(disable)
        for (int t = 0; t < nt; t += 2) {
            const bool last = (t == nt - 2);
            if (pend && t == 2) { E.flush(psum, pu, wr, fr, fq); pend = false; }
            const char* a1 = cA + (size_t)(t + 1) * kstep;
            const char* a2 = last ? nA : cA + (size_t)(t + 2) * kstep; const char* b2 = last ? nB : cB + (size_t)(t + 2) * kstep;
            const char* a3 = a2 + kstep; const char* b3 = b2 + kstep;
            PG8_LDB(B0, 0, 0); PG8_SCHED; PG8_LDA(At, 0, 0); PG8_STAGE(PG8_SA(1, 1), a1 + hstepA, voffA);
            PG8_WAIT_L(8); PG8_BAR; PG8_WAIT_L(0); PG8_MMA(0, 0, At, B0); PG8_BAR; PG8_SCHED;
            PG8_LDB(B1, 0, 1); PG8_STAGE(PG8_SB(0, 0), b2, voffB);
            PG8_BAR; PG8_WAIT_L(0); PG8_MMA(0, 1, At, B1); PG8_BAR;
            PG8_LDA(At, 0, 1); PG8_STAGE(PG8_SA(0, 0), a2, voffA);
            PG8_BAR; PG8_WAIT_L(0); PG8_MMA(1, 0, At, B0); PG8_BAR; PG8_SCHED;
            PG8_STAGE(PG8_SB(0, 1), b2 + hstepB, voffB);
            PG8_WAIT_V(6); PG8_BAR; PG8_MMA(1, 1, At, B1); PG8_BAR;
            PG8_LDB(B0, 1, 0); PG8_SCHED; PG8_LDA(At, 1, 0); PG8_STAGE(PG8_SA(0, 1), a2 + hstepA, voffA);
            PG8_WAIT_L(8); PG8_BAR; PG8_WAIT_L(0); PG8_MMA(0, 0, At, B0); PG8_BAR; PG8_SCHED;
            PG8_LDB(B1, 1, 1); PG8_STAGE(PG8_SB(1, 0), b3, voffB);
            PG8_BAR; PG8_WAIT_L(0); PG8_MMA(0, 1, At, B1); PG8_BAR;
            PG8_LDA(At, 1, 1); PG8_STAGE(PG8_SA(1, 0), a3, voffA);
            PG8_BAR; PG8_WAIT_L(0); PG8_MMA(1, 0, At, B0); PG8_BAR; PG8_SCHED;
            PG8_STAGE(PG8_SB(1, 1), b3 + hstepB, voffB);
            PG8_WAIT_V(6); PG8_BAR; PG8_MMA(1, 1, At, B1); PG8_BAR;
        }
        pend = E(acc, cur, wr, wc, fr, fq, psum); pu = cur;
        if (!has_next) { if (pend) E.flush(psum, pu, wr, fr, fq); break; }
#pragma unroll
        for (int a = 0; a < 2; ++a)
#pragma unroll
            for (int b = 0; b < 2; ++b)
#pragma unroll
                for (int m = 0; m < 4; ++m)
#pragma unroll
                    for (int n = 0; n < 2; ++n) acc[a][b][m][n] = (f32x4){0.f, 0.f, 0.f, 0.f};
        cur = nxt; cA = nA; cB = nB; ++ui;
    }
    PG8_WAIT_V(0);
    if (wr == 0) PG8_BAR;
    PG8_BAR;
#undef PG8_SA
#undef PG8_SB
#undef PG8_STAGE
#undef PG8_LDA
#undef PG8_LDB
#undef PG8_MMA
#undef PG8_WAIT_V
#undef PG8_WAIT_L
#undef PG8_BAR
#undef PG8_SCHED
}
}

template <int MODE> struct Epi {
    static constexpr bool PERM = true;
    bf16_t* o16; int ld16; float* H; const float* resid; const float* ss_in; float* ss_out; const bf16_t* E; const float* ssE; const float* pnorm; float* glr; int dummy; const bf16_t* resid16;
    __device__ __forceinline__ void flush(const float (&sums)[8], const pg8::Unit& u, int wr, int fr, int fq) const {
        if (fq == 0) {
#pragma unroll
            for (int q = 0; q < 8; ++q) atomicAdd(ss_out + u.pm * 256 + wr * 64 + fr + (q >> 2) * 128 + (q & 3) * 16, sums[q]);
        }
    }
    __device__ __forceinline__ bool operator()(const f32x4 (&acc)[2][2][4][2], const pg8::Unit& u, int wr, int wc, int fr, int fq, float (&sums)[8]) const {
        const int row0 = u.pm * 256 + wr * 64 + fr, col0 = u.pn * 256 + wc * 32 + 8 * fq;
        int kind = 0;
        if (MODE == 1) { const int pn = u.pn; kind = pn < 4 ? 0 : (pn == 4 ? 1 : (pn < 9 ? 2 : (pn < 13 ? 3 : (pn < 17 ? 4 : 2)))); }
        if (MODE == 5) { const int pn = u.pn; kind = ((pn >= 8 && pn < 12) || (pn >= 16 && pn < 20)) ? 2 : 1; }
        float rsv[2][4], rEv[2][4];
#pragma unroll
        for (int ai = 0; ai < 2; ++ai)
#pragma unroll
            for (int m = 0; m < 4; ++m) {
                const int row = row0 + ai * 128 + m * 16;
                rsv[ai][m] = (MODE == 1 || MODE == 4 || MODE == 5) ? ss_in[row] : 0.f;
                rEv[ai][m] = (MODE == 4) ? ssE[row] : 0.f;
            }
        f32x4 pnv[2][2];
        if (MODE == 4) {
#pragma unroll
            for (int bj = 0; bj < 2; ++bj) { pnv[bj][0] = *(const f32x4*)(pnorm + col0 + bj * 128); pnv[bj][1] = *(const f32x4*)(pnorm + col0 + bj * 128 + 4); }
        }
#pragma unroll
        for (int ai = 0; ai < 2; ++ai)
#pragma unroll
            for (int m = 0; m < 4; ++m) { rsv[ai][m] = rsqrtf(rsv[ai][m] * (1.f / 2048.f) + 1e-6f); rEv[ai][m] = rsqrtf(rEv[ai][m] * (1.f / 2048.f) + 1e-6f); }
#pragma unroll
        for (int ai = 0; ai < 2; ++ai)
#pragma unroll
        for (int mh = 0; mh < 2; ++mh) {
            u32x4 rw[4][2], ew[4][2]; f32x4 rf[4][2][2];
            if (MODE == 3 || MODE == 4) {
#pragma unroll
                for (int m = 2 * mh; m < 2 * mh + 2; ++m)
#pragma unroll
                    for (int bj = 0; bj < 2; ++bj) {
                        const size_t off = (size_t)(row0 + ai * 128 + m * 16) * DM + col0 + bj * 128;
                        if (MODE == 4) { rw[m][bj] = *(const u32x4*)(resid16 + off); ew[m][bj] = *(const u32x4*)(E + off); }
                        if (MODE == 3) {
                            if (resid16 != nullptr) rw[m][bj] = *(const u32x4*)(resid16 + off);
                            else { rf[m][bj][0] = *(const f32x4*)(resid + off); rf[m][bj][1] = *(const f32x4*)(resid + off + 4); }
                        }
                    }
            }
#pragma unroll
            for (int m = 2 * mh; m < 2 * mh + 2; ++m) {
                const int row = row0 + ai * 128 + m * 16;
                const float rs = rsv[ai][m], rE = rEv[ai][m];
                float ssq = 0.f;
#pragma unroll
                for (int bj = 0; bj < 2; ++bj) {
                    const int col = col0 + bj * 128;
                    const f32x4 a0 = acc[ai][bj][m][0], a1 = acc[ai][bj][m][1];
                    float v[8] = {a0[0], a0[1], a0[2], a0[3], a1[0], a1[1], a1[2], a1[3]};
                    if (MODE == 1) {
#pragma unroll
                        for (int e = 0; e < 8; ++e) v[e] *= rs;
                        if (kind == 0) {
#pragma unroll
                            for (int e = 0; e < 8; ++e) v[e] *= 0.125f;
                        } else if (kind == 2) {
#pragma unroll
                            for (int e = 0; e < 8; ++e) v[e] = silu_f(v[e]);
                        } else if (kind >= 3) {
#pragma unroll
                            for (int e = 0; e < 8; e += 2) { f32x2 r = gelu_pk((f32x2){v[e], v[e + 1]}); v[e] = r.x; v[e + 1] = r.y; }
                            if (kind == 4) {
#pragma unroll
                                for (int e = 0; e < 8; ++e) ssq += v[e] * v[e];
                            }
                        }
                    }
                    if (MODE == 2) {
#pragma unroll
                        for (int e = 0; e < 8; ++e) ssq += v[e] * v[e];
                    }
                    if (MODE == 3) {
                        if (resid16 != nullptr) {
#pragma unroll
                            for (int e = 0; e < 4; ++e) { v[2 * e] += __uint_as_float(rw[m][bj][e] << 16); v[2 * e + 1] += __uint_as_float(rw[m][bj][e] & 0xffff0000u); }
                        } else {
#pragma unroll
                            for (int e = 0; e < 4; ++e) { v[e] += rf[m][bj][0][e]; v[e + 4] += rf[m][bj][1][e]; }
                        }
#pragma unroll
                        for (int e = 0; e < 8; ++e) ssq += v[e] * v[e];
                    }
                    if (MODE == 4) {
                        const float nv[8] = {pnv[bj][0][0], pnv[bj][0][1], pnv[bj][0][2], pnv[bj][0][3], pnv[bj][1][0], pnv[bj][1][1], pnv[bj][1][2], pnv[bj][1][3]};
#pragma unroll
                        for (int e = 0; e < 8; ++e) {
                            const float hv = (e & 1) ? __uint_as_float(rw[m][bj][e >> 1] & 0xffff0000u) : __uint_as_float(rw[m][bj][e >> 1] << 16);
                            const float evv = (e & 1) ? __uint_as_float(ew[m][bj][e >> 1] & 0xffff0000u) : __uint_as_float(ew[m][bj][e >> 1] << 16);
                            const float gte = fast_sigmoid(v[e] * rs); v[e] = hv + evv * rE * nv[e] * gte; ssq += v[e] * v[e]; }
                    }
                    if (MODE == 5) {
#pragma unroll
                        for (int e = 0; e < 8; ++e) v[e] *= rs;
                        if (kind == 2) {
#pragma unroll
                            for (int e = 0; e < 8; ++e) v[e] = silu_f(v[e]);
                        }
                    }
                    if (!dummy || v[0] == 12345.678f) {
                        u32x4 w; w.x = cvt_pk_bf16(v[0], v[1]); w.y = cvt_pk_bf16(v[2], v[3]); w.z = cvt_pk_bf16(v[4], v[5]); w.w = cvt_pk_bf16(v[6], v[7]);
                        *(u32x4*)(o16 + (size_t)row * ld16 + col) = w;
                    }
                }
                if (MODE == 2 || MODE == 3 || MODE == 4 || (MODE == 1 && kind == 4)) {
                    ssq += __shfl_xor(ssq, 16); ssq += __shfl_xor(ssq, 32);
                    sums[ai * 4 + m] = ssq;
                }
            }
        }
        return (MODE == 2 || MODE == 3 || MODE == 4 || (MODE == 1 && kind == 4));
    }
};

__device__ __forceinline__ int map_in1(int n) {
    if (n < 2048) return n;
    if (n < 4096) return n + 1024;
    if (n < 5120) return n + 2064;
    if (n < 6144) return n - 3072;
    if (n < 7184) return n - 1024;
    return -1;
}
__device__ __forceinline__ void wtrans_tile(const float* W, int K, int Nsrc, bf16_t* Wt, const float* gain, int mapk, int tk, int tn, LAS float* tl) {
    const int tid = threadIdx.x, tx = tid & 255, ty = tid >> 8;
    const int k0 = tk * 64, n0 = tn * 256;
    int sc = n0 + tx; if (mapk) sc = map_in1(sc);
    float v[32];
#pragma unroll
    for (int i = 0; i < 32; ++i) { const int kk = ty + 2 * i; v[i] = (sc >= 0) ? W[(size_t)(k0 + kk) * Nsrc + sc] : 0.f; }
    if (gain) {
#pragma unroll
        for (int i = 0; i < 32; ++i) v[i] *= gain[k0 + ty + 2 * i];
    }
#pragma unroll
    for (int i = 0; i < 32; ++i) tl[(ty + 2 * i) * 257 + tx] = v[i];
    __syncthreads();
#pragma unroll
    for (int p = 0; p < 4; ++p) {
        const int n = p * 64 + (tid >> 3), seg = (tid & 7) * 8; float o[8];
#pragma unroll
        for (int j = 0; j < 8; ++j) o[j] = tl[(seg + j) * 257 + n];
        u32x4 w; w.x = cvt_pk_bf16(o[0], o[1]); w.y = cvt_pk_bf16(o[2], o[3]); w.z = cvt_pk_bf16(o[4], o[5]); w.w = cvt_pk_bf16(o[6], o[7]);
        *(u32x4*)(Wt + (size_t)(n0 + n) * K + k0 + seg) = w;
    }
    __syncthreads();
}
__device__ __forceinline__ void phase_wconv(const Params& P, LAS unsigned char* lds, int gbeg, int gend, int bid, int nb);
__device__ __forceinline__ void phase_prep(const Params& P, LAS unsigned char* lds, int bid, int nb) {
    const int tid = threadIdx.x, wid = tid >> 6, lane = tid & 63;
    unsigned char* ws = P.ws;
    float* stat = (float*)(ws + WS_STAT);
    for (int i = bid * 512 + tid; i < 7 * SEQ; i += nb * 512) stat[SEQ + i] = 0.f;
    { bf16_t* xb = (bf16_t*)(ws + WS_HA);
      for (int row = bid * 16 + wid * 2; row < SEQ; row += nb * 16) {
          const float* xr = P.x + (size_t)row * DM; float s0 = 0.f, s1 = 0.f;
          f32x4 va[8], vb[8];
#pragma unroll
          for (int i = 0; i < 8; ++i) { va[i] = *(const f32x4*)(xr + lane * 4 + 256 * i); vb[i] = *(const f32x4*)(xr + DM + lane * 4 + 256 * i); }
#pragma unroll
          for (int i = 0; i < 8; ++i) {
              s0 += va[i][0] * va[i][0] + va[i][1] * va[i][1] + va[i][2] * va[i][2] + va[i][3] * va[i][3];
              s1 += vb[i][0] * vb[i][0] + vb[i][1] * vb[i][1] + vb[i][2] * vb[i][2] + vb[i][3] * vb[i][3];
              u32x2 w; w.x = cvt_pk_bf16(va[i][0], va[i][1]); w.y = cvt_pk_bf16(va[i][2], va[i][3]); *(u32x2*)(xb + (size_t)row * DM + lane * 4 + 256 * i) = w;
              u32x2 w2; w2.x = cvt_pk_bf16(vb[i][0], vb[i][1]); w2.y = cvt_pk_bf16(vb[i][2], vb[i][3]); *(u32x2*)(xb + (size_t)(row + 1) * DM + lane * 4 + 256 * i) = w2; }
#pragma unroll
          for (int o = 1; o < 64; o <<= 1) { s0 += __shfl_xor(s0, o); s1 += __shfl_xor(s1, o); }
          if (lane == 0) { stat[row] = s0; stat[row + 1] = s1; }
      } }
    { bf16_t* pb = (bf16_t*)(ws + WS_PB);
      const size_t total = (size_t)2 * SEQ * 256, stride = (size_t)nb * 512 * 4;
      for (size_t i0 = (size_t)(bid * 512 + tid) * 4; i0 < total; i0 += stride * 8) {
          f32x4 v[8];
#pragma unroll
          for (int q = 0; q < 8; ++q) { const size_t i = i0 + stride * q; v[q] = (i < total) ? *(const f32x4*)(P.p + i) : (f32x4){0.f, 0.f, 0.f, 0.f}; }
#pragma unroll
          for (int q = 0; q < 8; ++q) { const size_t i = i0 + stride * q; if (i < total) { u32x2 w; w.x = cvt_pk_bf16(v[q][0], v[q][1]); w.y = cvt_pk_bf16(v[q][2], v[q][3]); *(u32x2*)(pb + i) = w; } }
      } }
    phase_wconv(P, lds, 0, 32 * 21 + 256 + 256 + 32, bid, nb);
}
__device__ __forceinline__ void phase_wconv(const Params& P, LAS unsigned char* lds, int gbeg, int gend, int bid, int nb) {
    unsigned char* ws = P.ws;
    { LAS float* tl = (LAS float*)lds;
      const int c0 = 32 * 21, c1 = c0 + 256, c2 = c1 + 256, c3 = c2 + 32, c4 = c3 + 32 * 29, c5 = c4 + 256, c6 = c5 + 256;
      for (int g = gbeg + bid; g < gend; g += nb) {
          if (g < c0) wtrans_tile(P.w_in_even, 2048, 5376, (bf16_t*)(ws + WS_WIN0), P.norm_mix, 0, g % 32, g / 32, tl);
          else if (g < c1) { const int t = g - c0; wtrans_tile(P.w_out_even, 2048, 2048, (bf16_t*)(ws + WS_WOUT0), nullptr, 0, t % 32, t / 32, tl); }
          else if (g < c2) { const int t = g - c1; wtrans_tile(P.w_ple_gate, 2048, 2048, (bf16_t*)(ws + WS_WG0), P.ple_gate_norm, 0, t % 32, t / 32, tl); }
          else if (g < c3) { const int t = g - c2; wtrans_tile(P.w_ple_proj, 256, 2048, (bf16_t*)(ws + WS_WP0), nullptr, 0, t % 4, t / 4, tl); }
          else if (g < c4) { const int t = g - c3; wtrans_tile(P.w_in_odd, 2048, 7184, (bf16_t*)(ws + WS_WIN1), P.norm_mix + DM, 1, t % 32, t / 32, tl); }
          else if (g < c5) { const int t = g - c4; wtrans_tile(P.w_out_odd, 2048, 2048, (bf16_t*)(ws + WS_WOUT1), nullptr, 0, t % 32, t / 32, tl); }
          else if (g < c6) { const int t = g - c5; wtrans_tile(P.w_ple_gate + (size_t)DM * DM, 2048, 2048, (bf16_t*)(ws + WS_WG1), P.ple_gate_norm + DM, 0, t % 32, t / 32, tl); }
          else { const int t = g - c6; wtrans_tile(P.w_ple_proj + (size_t)256 * DM, 256, 2048, (bf16_t*)(ws + WS_WP1), nullptr, 0, t % 4, t / 4, tl); }
      } }
}

__device__ __forceinline__ void attn_unit(const Params& P, LAS unsigned char* lds, int n, int g) {
    const int tid = threadIdx.x, w = tid >> 6, lane = tid & 63, l15 = lane & 15, quad = lane >> 4;
    const bf16_t* Z = (const bf16_t*)(P.ws + WS_Z);
    bf16_t* Y = (bf16_t*)(P.ws + WS_HA);
    constexpr int KS = 0, VT = 36864, PB = 70656;
#pragma unroll
    for (int r = 0; r < 4; ++r) {
        { const int idx = tid + 512 * r, key = idx >> 3, c8 = idx & 7; u32x4 v = (u32x4){0u, 0u, 0u, 0u};
          if (n > 0 || key >= 128) v = *(const u32x4*)(Z + (size_t)(128 * (n - 1) + key) * LDZ0 + 1024 + g * 64 + c8 * 8);
          *(LAS u32x4*)(lds + KS + key * 144 + c8 * 16) = v; }
        { const int idx = tid + 512 * r, key = idx & 255, c8 = idx >> 8; u32x4 v = (u32x4){0u, 0u, 0u, 0u};
          if (n > 0 || key >= 128) v = *(const u32x4*)(Z + (size_t)(128 * (n - 1) + key) * LDZ0 + 1152 + g * 64 + c8 * 8);
#pragma unroll
          for (int e = 0; e < 4; ++e) { *(LAS bf16_t*)(lds + VT + (c8 * 8 + 2 * e) * 528 + key * 2) = (bf16_t)(v[e] & 0xffffu); *(LAS bf16_t*)(lds + VT + (c8 * 8 + 2 * e + 1) * 528 + key * 2) = (bf16_t)(v[e] >> 16); } }
    }
    __syncthreads();
    const int hq = g * 8 + w;
    const float sink = P.sinks[hq];
    LAS unsigned char* pw = lds + PB + w * 5376;
    bf16x8 q0n, q1n; u32x2 gwn[4];
    { const size_t qrow = (size_t)(128 * n + l15);
      q0n = *(const bf16x8*)(Z + qrow * LDZ0 + hq * 64 + quad * 8); q1n = *(const bf16x8*)(Z + qrow * LDZ0 + hq * 64 + 32 + quad * 8);
#pragma unroll
      for (int nt = 0; nt < 4; ++nt) gwn[nt] = *(const u32x2*)(Z + qrow * LDZ0 + 1280 + hq * 64 + 16 * nt + quad * 4); }
    for (int rg = 0; rg < 8; ++rg) {
        const int kt0 = rg < 6 ? rg : 6;
        const bf16x8 q0 = q0n, q1 = q1n;
        u32x2 gwc[4];
#pragma unroll
        for (int nt = 0; nt < 4; ++nt) gwc[nt] = gwn[nt];
        if (rg < 7) {
            const size_t qrow = (size_t)(128 * n + 16 * (rg + 1) + l15);
            q0n = *(const bf16x8*)(Z + qrow * LDZ0 + hq * 64 + quad * 8); q1n = *(const bf16x8*)(Z + qrow * LDZ0 + hq * 64 + 32 + quad * 8);
#pragma unroll
            for (int nt = 0; nt < 4; ++nt) gwn[nt] = *(const u32x2*)(Z + qrow * LDZ0 + 1280 + hq * 64 + 16 * nt + quad * 4);
        }
        f32x4 s[10];
#pragma unroll
        for (int t = 0; t < 10; ++t) {
            const int key = 16 * (kt0 + t) + l15;
            const bf16x8 k0 = *(const LAS bf16x8*)(lds + KS + key * 144 + quad * 16), k1 = *(const LAS bf16x8*)(lds + KS + key * 144 + 64 + quad * 16);
            f32x4 a = (f32x4){0.f, 0.f, 0.f, 0.f};
            a = MFMA16(q0, k0, a); a = MFMA16(q1, k1, a);
            s[t] = a;
        }
        float mx[4], sm[4];
        if (n > 0 && rg < 7) {
#pragma unroll
            for (int j = 0; j < 4; ++j) { const int qr = quad * 4 + j;
                s[0][j] = (l15 > qr) ? s[0][j] : -1e30f; s[8][j] = (l15 <= qr) ? s[8][j] : -1e30f; s[9][j] = -1e30f; }
        } else {
#pragma unroll
            for (int j = 0; j < 4; ++j) { const int qi = 16 * rg + quad * 4 + j;
#pragma unroll
                for (int t = 0; t < 10; ++t) { const int kj = 16 * (kt0 + t) + l15; const bool valid = (kj > qi) && (kj <= qi + 128) && (n > 0 || kj >= 128);
                    s[t][j] = valid ? s[t][j] : -1e30f; } }
        }
#pragma unroll
        for (int j = 0; j < 4; ++j) {
            float m = -1e30f;
#pragma unroll
            for (int t = 0; t < 10; ++t) m = fmaxf(m, s[t][j]);
            m = fmaxf(m, __shfl_xor(m, 1)); m = fmaxf(m, __shfl_xor(m, 2)); m = fmaxf(m, __shfl_xor(m, 4)); m = fmaxf(m, __shfl_xor(m, 8));
            m = fmaxf(m, sink); mx[j] = m;
            float su = 0.f;
#pragma unroll
            for (int t = 0; t < 10; ++t) { const float pv = __expf(s[t][j] - m); s[t][j] = pv; su += pv; }
            su += __shfl_xor(su, 1); su += __shfl_xor(su, 2); su += __shfl_xor(su, 4); su += __shfl_xor(su, 8);
            su += __expf(sink - m); sm[j] = 1.0f / su;
        }
#pragma unroll
        for (int t = 0; t < 10; ++t)
#pragma unroll
            for (int j = 0; j < 4; ++j) *(LAS bf16_t*)(pw + (quad * 4 + j) * 336 + (16 * t + l15) * 2) = f2bf(s[t][j]);
        f32x4 o[4];
#pragma unroll
        for (int nt = 0; nt < 4; ++nt) o[nt] = (f32x4){0.f, 0.f, 0.f, 0.f};
#pragma unroll
        for (int s5 = 0; s5 < 5; ++s5) {
            const bf16x8 pa = *(const LAS bf16x8*)(pw + l15 * 336 + (32 * s5 + quad * 8) * 2);
#pragma unroll
            for (int nt = 0; nt < 4; ++nt) {
                const bf16x8 vb = *(const LAS bf16x8*)(lds + VT + (16 * nt + l15) * 528 + (16 * kt0 + 32 * s5 + quad * 8) * 2);
                o[nt] = MFMA16(vb, pa, o[nt]);
            }
        }
        float smq;
        { const int src = (l15 >> 2) << 4; const float t0 = __shfl(sm[0], src), t1 = __shfl(sm[1], src), t2 = __shfl(sm[2], src), t3 = __shfl(sm[3], src);
          const int jj = l15 & 3; smq = jj == 0 ? t0 : (jj == 1 ? t1 : (jj == 2 ? t2 : t3)); }
        { const size_t row = (size_t)(128 * n + 16 * rg + l15);
#pragma unroll
          for (int nt = 0; nt < 4; ++nt) {
              const int d0 = 16 * nt + quad * 4;
              const u32x2 gw = gwc[nt];
              u32x2 yw;
              yw.x = cvt_pk_bf16(o[nt][0] * smq * __uint_as_float(gw.x << 16), o[nt][1] * smq * __uint_as_float(gw.x & 0xffff0000u));
              yw.y = cvt_pk_bf16(o[nt][2] * smq * __uint_as_float(gw.y << 16), o[nt][3] * smq * __uint_as_float(gw.y & 0xffff0000u));
              *(u32x2*)(Y + row * DM + hq * 64 + d0) = yw;
          } }
    }
    __syncthreads();
}
__device__ __forceinline__ void gmlp_unit(const Params& P, LAS unsigned char* lds, int n, int g) {
    const int tid = threadIdx.x, w = tid >> 6, lane = tid & 63, l15 = lane & 15, quad = lane >> 4;
    const bf16_t* Z = (const bf16_t*)(P.ws + WS_Z);
    bf16_t* Y = (bf16_t*)(P.ws + WS_HA);
    const float* ssv = (const float*)(P.ws + WS_STAT) + SEQ;
    const int trow = 16 * w + l15;
    const float* wsp = P.w_sp + ((size_t)g * 128 + trow) * 128;
    f32x4 wq[4][2];
#pragma unroll
    for (int ks = 0; ks < 4; ++ks) {
        wq[ks][0] = (f32x4){0.f, 0.f, 0.f, 0.f}; wq[ks][1] = (f32x4){0.f, 0.f, 0.f, 0.f};
        if (32 * ks <= 16 * w + 15) { wq[ks][0] = *(const f32x4*)(wsp + 32 * ks + quad * 8); wq[ks][1] = *(const f32x4*)(wsp + 32 * ks + quad * 8 + 4); }
    }
    u32x2 uwv[8], gwv[8];
#pragma unroll
    for (int nt = 0; nt < 8; ++nt) {
        const size_t row = (size_t)(128 * n + trow); const int c0 = g * 128 + 16 * nt + quad * 4;
        uwv[nt] = *(const u32x2*)(Z + row * LDZ0 + 2304 + c0); gwv[nt] = *(const u32x2*)(Z + row * LDZ0 + 4352 + c0);
    }
    const float bs = P.b_sp[g * 128 + trow];
#pragma unroll
    for (int r = 0; r < 4; ++r) {
        const int idx = tid + 512 * r, s = idx & 127, c8 = idx >> 7;
        const u32x4 v = *(const u32x4*)(Z + (size_t)(128 * n + s) * LDZ0 + 3328 + g * 128 + c8 * 8);
        const float rinv = rsqrtf(ssv[128 * n + s] * (1.f / 1024.f) + 1e-6f);
#pragma unroll
        for (int e = 0; e < 4; ++e) {
            const int c = c8 * 8 + 2 * e;
            const float lo = __uint_as_float(v[e] << 16) * rinv * P.vnorm[g * 128 + c], hi = __uint_as_float(v[e] & 0xffff0000u) * rinv * P.vnorm[g * 128 + c + 1];
            *(LAS bf16_t*)(lds + c * 272 + s * 2) = f2bf(lo); *(LAS bf16_t*)(lds + (c + 1) * 272 + s * 2) = f2bf(hi);
        }
    }
    __syncthreads();
    f32x4 acc[8];
#pragma unroll
    for (int nt = 0; nt < 8; ++nt) acc[nt] = (f32x4){0.f, 0.f, 0.f, 0.f};
#pragma unroll
    for (int ks = 0; ks < 4; ++ks) {
        if (32 * ks <= 16 * w + 15) {
            const int s0 = 32 * ks + quad * 8;
            const f32x4 w0 = wq[ks][0], w1 = wq[ks][1];
            float wv[8] = {w0[0], w0[1], w0[2], w0[3], w1[0], w1[1], w1[2], w1[3]};
#pragma unroll
            for (int e = 0; e < 8; ++e) if (s0 + e > trow) wv[e] = 0.f;
            u32x4 aw; aw.x = cvt_pk_bf16(wv[0], wv[1]); aw.y = cvt_pk_bf16(wv[2], wv[3]); aw.z = cvt_pk_bf16(wv[4], wv[5]); aw.w = cvt_pk_bf16(wv[6], wv[7]);
            const bf16x8 af = __builtin_bit_cast(bf16x8, aw);
#pragma unroll
            for (int nt = 0; nt < 8; ++nt) { const bf16x8 bfv = *(const LAS bf16x8*)(lds + (16 * nt + l15) * 272 + s0 * 2); acc[nt] = MFMA16(bfv, af, acc[nt]); }
        }
    }
    { const int t = 16 * w + l15; const size_t row = (size_t)(128 * n + t);
#pragma unroll
      for (int nt = 0; nt < 8; ++nt) {
          const int c0 = g * 128 + 16 * nt + quad * 4;
          const u32x2 uw = uwv[nt], gw = gwv[nt];
          u32x2 yw;
          yw.x = cvt_pk_bf16(__uint_as_float(uw.x << 16) * (acc[nt][0] + bs) * __uint_as_float(gw.x << 16), __uint_as_float(uw.x & 0xffff0000u) * (acc[nt][1] + bs) * __uint_as_float(gw.x & 0xffff0000u));
          yw.y = cvt_pk_bf16(__uint_as_float(uw.y << 16) * (acc[nt][2] + bs) * __uint_as_float(gw.y << 16), __uint_as_float(uw.y & 0xffff0000u) * (acc[nt][3] + bs) * __uint_as_float(gw.y & 0xffff0000u));
          *(u32x2*)(Y + row * DM + 1024 + c0) = yw;
      } }
    __syncthreads();
}
__device__ __forceinline__ void phase_mix0(const Params& P, LAS unsigned char* lds, int bid, int nb) {
    for (int u = bid; u < 256; u += nb) attn_unit(P, lds, u >> 1, u & 1);
    for (int u = bid; u < 1024; u += nb) gmlp_unit(P, lds, u >> 3, u & 7);
}

struct FrontC { float lbv, bg; float wu[16]; };
template <int MIX>
__device__ __forceinline__ void front_consts(const Params& P, int h, FrontC& C) {
    const int c = h * 128 + (threadIdx.x & 127);
    C.lbv = 0.f; C.bg = 0.f;
    if (MIX == 0) C.lbv = __builtin_amdgcn_rcpf(1.0f + __expf(P.lower_bounds[c] - P.lower_bounds[1024 + c]));
    else {
#pragma unroll
        for (int r = 0; r < 16; ++r) C.wu[r] = P.w_gate_up[r * 512 + c];
        C.bg = P.b_gate[c];
    }
}
template <int MIX>
__device__ __forceinline__ void front_load(const Params& P, int n, int h, float (&zr)[16], f32x4& gq) {
    const int tid = threadIdx.x, kk = tid & 127, i = tid >> 7;
    const bf16_t* Z = (const bf16_t*)(P.ws + WS_Z);
    const int col = (MIX ? 3584 : 1024) + h * 128 + kk;
#pragma unroll
    for (int tt = 0; tt < 16; ++tt) zr[tt] = bf2f(Z[(size_t)(64 * n + 16 * i + tt) * LDZ1 + col]);
    if (MIX) {
        const int iu = __builtin_amdgcn_readfirstlane(i);
        const float* glr = (const float*)(P.ws + WS_GLR) + (size_t)(64 * n + 16 * iu) * 16;
        gq = *(const f32x4*)(glr + 4 * (threadIdx.x & 63));
    }
}
template <int MIX>
__device__ __forceinline__ void front_compute(LAS unsigned char* lds, const FrontC& C, const float (&zr)[16], const f32x4& gq, float (&loc)[16], float (&kv)[16], float (&o)[5]) {
    const int tid = threadIdx.x, kk = tid & 127, i = tid >> 7;
    LAS float* segtot = (LAS float*)lds;
    float run = 0.f;
    if (MIX == 0) {
        const float lbv = C.lbv;
#pragma unroll
        for (int tt = 0; tt < 16; ++tt) {
            const float z = zr[tt];
            const float en = __expf(-fabsf(z)), r = __builtin_amdgcn_rcpf(1.0f + en);
            const float sg = z >= 0.f ? r : en * r, omsg = z >= 0.f ? en * r : r;
            const float f = lbv + (1.0f - lbv) * sg;
            run += __logf(f); loc[tt] = run; kv[tt] = (1.0f - lbv) * omsg;
        }
    } else {
#pragma unroll
        for (int tt = 0; tt < 16; ++tt) {
            float xg = C.bg;
#pragma unroll
            for (int r = 0; r < 16; ++r) {
                const float gv = __int_as_float(__builtin_amdgcn_readlane(__float_as_int(gq[r & 3]), 4 * tt + (r >> 2)));
                xg += gv * C.wu[r];
            }
            const float ls = fminf(xg, 0.f) - __logf(1.0f + __expf(-fabsf(xg)));
            run += ls * (1.0f / 16.0f); loc[tt] = run; kv[tt] = zr[tt];
        }
    }
    segtot[i * 128 + kk] = run;
    __syncthreads();
    o[0] = 0.f;
#pragma unroll
    for (int q = 0; q < 4; ++q) o[q + 1] = o[q] + segtot[q * 128 + kk];
}
template <int MIX>
__device__ __forceinline__ void chunk_front(const Params& P, LAS unsigned char* lds, int n, int h, float (&loc)[16], float (&kv)[16], float (&o)[5]) {
    FrontC C; float zr[16]; f32x4 gq = (f32x4){0.f, 0.f, 0.f, 0.f};
    front_consts<MIX>(P, h, C);
    front_load<MIX>(P, n, h, zr, gq);
    front_compute<MIX>(lds, C, zr, gq, loc, kv, o);
}
template <int DV>
__device__ __forceinline__ void load_v(const bf16_t* vsrc, u32x4 (&vr)[DV / 64]) {
    const int tid = threadIdx.x;
#pragma unroll
    for (int r = 0; r < DV / 128; ++r) { const int idx = tid + 512 * r, s2 = idx & 31, c8 = idx >> 5;
        vr[2 * r] = *(const u32x4*)(vsrc + (size_t)(2 * s2) * LDZ1 + c8 * 8); vr[2 * r + 1] = *(const u32x4*)(vsrc + (size_t)(2 * s2 + 1) * LDZ1 + c8 * 8); }
}
template <int DV>
__device__ __forceinline__ void store_vt(const u32x4 (&vr)[DV / 64], LAS unsigned char* vt) {
    const int tid = threadIdx.x;
#pragma unroll
    for (int r = 0; r < DV / 128; ++r) {
        const int idx = tid + 512 * r, s2 = idx & 31, c8 = idx >> 5;
        const u32x4 a = vr[2 * r], b = vr[2 * r + 1];
#pragma unroll
        for (int e = 0; e < 4; ++e) {
            *(LAS unsigned*)(vt + (c8 * 8 + 2 * e) * 144 + s2 * 4) = (a[e] & 0xffffu) | (b[e] << 16);
            *(LAS unsigned*)(vt + (c8 * 8 + 2 * e + 1) * 144 + s2 * 4) = (a[e] >> 16) | (b[e] & 0xffff0000u);
        }
    }
}
template <int MIX>
__device__ __forceinline__ void scanA_unit(const Params& P, LAS unsigned char* lds, int n, int h, const FrontC& C, const float (&zr)[16], const f32x4& gq, const u32x4 (&vr)[(MIX ? 256 : 128) / 64]) {
    constexpr int DV = MIX ? 256 : 128, NH = MIX ? 4 : 8;
    const int tid = threadIdx.x, kk = tid & 127, i = tid >> 7, w = tid >> 6, lane = tid & 63, l15 = lane & 15, quad = lane >> 4;
    const bf16_t* Z = (const bf16_t*)(P.ws + WS_Z);
    bf16_t* ST = (bf16_t*)((unsigned char*)P.out + (MIX ? (size_t)SEQ * DM * 2 : 0)) + ((size_t)n * NH + h) * DV * 128;
    float* dbuf = (float*)(P.ws + WS_DBUF);
    constexpr int KD = 2048, VT = 2048 + 18432;
    float loc[16], kv[16], o[5];
    front_compute<MIX>(lds, C, zr, gq, loc, kv, o);
    { float e[16];
#pragma unroll
      for (int tt = 0; tt < 16; ++tt) e[tt] = kv[tt] * __expf(o[4] - o[i] - loc[tt]);
      u32x4 w0, w1; w0.x = cvt_pk_bf16(e[0], e[1]); w0.y = cvt_pk_bf16(e[2], e[3]); w0.z = cvt_pk_bf16(e[4], e[5]); w0.w = cvt_pk_bf16(e[6], e[7]);
      w1.x = cvt_pk_bf16(e[8], e[9]); w1.y = cvt_pk_bf16(e[10], e[11]); w1.z = cvt_pk_bf16(e[12], e[13]); w1.w = cvt_pk_bf16(e[14], e[15]);
      *(LAS u32x4*)(lds + KD + kk * 144 + i * 32) = w0; *(LAS u32x4*)(lds + KD + kk * 144 + i * 32 + 16) = w1; }
    if (i == 0) dbuf[(size_t)n * 1536 + (MIX ? 1024 : 0) + h * 128 + kk] = __expf(o[4]);
    store_vt<DV>(vr, lds + VT);
    __syncthreads();
    f32x4 acc[DV / 16];
#pragma unroll
    for (int nt = 0; nt < DV / 16; ++nt) acc[nt] = (f32x4){0.f, 0.f, 0.f, 0.f};
#pragma unroll
    for (int ks = 0; ks < 2; ++ks) {
        const bf16x8 af = *(const LAS bf16x8*)(lds + KD + (16 * w + l15) * 144 + (32 * ks + quad * 8) * 2);
#pragma unroll
        for (int nt = 0; nt < DV / 16; ++nt) { const bf16x8 bfv = *(const LAS bf16x8*)(lds + VT + (16 * nt + l15) * 144 + (32 * ks + quad * 8) * 2); acc[nt] = MFMA16(af, bfv, acc[nt]); }
    }
#pragma unroll
    for (int nt = 0; nt < DV / 16; ++nt) { u32x2 wv; wv.x = cvt_pk_bf16(acc[nt][0], acc[nt][1]); wv.y = cvt_pk_bf16(acc[nt][2], acc[nt][3]);
        *(u32x2*)(ST + (size_t)(16 * nt + l15) * 128 + 16 * w + quad * 4) = wv; }
    __syncthreads();
}
__device__ __forceinline__ void phase_scanB(const Params& P, LAS unsigned char* lds, int bid, int nb) {
    const float* dbuf = (const float*)(P.ws + WS_DBUF);
    LAS float* ld = (LAS float*)lds;
    const int tid = threadIdx.x;
    for (int e0 = bid * 512; e0 < 131072; e0 += nb * 512) {
        const int e = e0 + tid;
        const int mix = e >> 16, r = e & 65535;
        const int h = mix ? (r >> 14) : (r >> 13);
        const float* dsrc = dbuf + (mix ? 1024 : 0) + h * 128;
#pragma unroll 16
        for (int j = 0; j < 64; ++j) { const int idx = tid + 512 * j; ld[idx] = dsrc[(size_t)(idx >> 7) * 1536 + (idx & 127)]; }
        __syncthreads();
        unsigned* base = (unsigned*)((unsigned char*)P.out + (mix ? (size_t)SEQ * DM * 2 : 0)) + r;
        const int kp = (r & 63) * 2;
        float s0 = 0.f, s1 = 0.f;
#pragma unroll 32
        for (int n = 0; n < 256; ++n) {
            const unsigned uw = __builtin_nontemporal_load(base + (size_t)n * 65536);
            const f32x2 d = *(const LAS f32x2*)(ld + n * 128 + kp);
            base[(size_t)n * 65536] = cvt_pk_bf16(s0, s1);
            s0 = d.x * s0 + __uint_as_float(uw << 16); s1 = d.y * s1 + __uint_as_float(uw & 0xffff0000u);
        }
        __syncthreads();
    }
}
template <int MIX>
__device__ __forceinline__ void scanC_unit(const Params& P, LAS unsigned char* lds, int n, int h, bool dummy) {
    constexpr int DV = MIX ? 256 : 128, NH = MIX ? 4 : 8, NTW = DV / 32;
    const int tid = threadIdx.x, kk = tid & 127, i = tid >> 7, w = __builtin_amdgcn_readfirstlane(tid >> 6), lane = tid & 63, l15 = lane & 15, quad = lane >> 4;
    bf16_t* Z = (bf16_t*)(P.ws + WS_Z);
    const bf16_t* ST = (const bf16_t*)((unsigned char*)P.out + (MIX ? (size_t)SEQ * DM * 2 : 0)) + ((size_t)n * NH + h) * DV * 128;
    constexpr int RS = 2048, QH = 2560, QT = 19968, KH0 = 37376, AB = 80896, VT = 90112;
    const int qcol = MIX ? 3072 + h * 128 : h * 128, vcol = MIX ? 6144 + h * 256 : 5120 + h * 128, gcol = MIX ? 4096 + h * 256 : 2048 + h * 128;
    const float* onorm = MIX ? P.onorm_d + h * 256 : P.onorm_c + h * 128;
    float loc[16], kv[16], o[5], qv[16];
    u32x4 vr[DV / 64];
#pragma unroll
    for (int tt = 0; tt < 16; ++tt) qv[tt] = bf2f(Z[(size_t)(64 * n + 16 * i + tt) * LDZ1 + qcol + kk]);
    load_v<DV>(Z + (size_t)(64 * n) * LDZ1 + vcol, vr);
    chunk_front<MIX>(P, lds, n, h, loc, kv, o);
    const int ip = w & 3, hv = w >> 2;
    bf16x8 sf[4][NTW]; u32x2 gwv[NTW];
    if (MIX == 0) {
#pragma unroll
        for (int ks = 0; ks < 4; ++ks)
#pragma unroll
            for (int nt = 0; nt < NTW; ++nt) sf[ks][nt] = *(const bf16x8*)(ST + (size_t)(16 * (hv * NTW + nt) + l15) * 128 + 32 * ks + quad * 8);
    }
#pragma unroll
    for (int nt = 0; nt < NTW; ++nt) gwv[nt] = *(const u32x2*)(Z + (size_t)(64 * n + 16 * ip + l15) * LDZ1 + gcol + 16 * (hv * NTW + nt) + quad * 4);
    const float scale = 0.08838834764831845f;
#ifndef CVAR
#define CVAR 0
#endif
    if (!(CVAR == 1 && dummy)) {
    { const float eo = __expf(o[i]);
#pragma unroll
      for (int tt = 0; tt < 16; ++tt) {
          const float q = qv[tt] * scale * __expf(loc[tt]);
          *(LAS bf16_t*)(lds + QH + (16 * i + tt) * 272 + kk * 2) = f2bf(q);
          *(LAS bf16_t*)(lds + QT + (16 * i + tt) * 272 + kk * 2) = f2bf(q * eo);
          kv[tt] *= __expf(-loc[tt]);
      } }
#pragma unroll
    for (int ip = 0; ip < 4; ++ip) {
        if (ip >= i) {
            const float fo = __expf(o[ip] - o[i]);
#pragma unroll
            for (int tt = 0; tt < 16; ++tt) *(LAS bf16_t*)(lds + KH0 + 4352 * (ip * (ip + 1) / 2) + (16 * i + tt) * 272 + kk * 2) = f2bf(kv[tt] * fo);
        }
    }
    }
    if (!(CVAR == 3 && dummy)) store_vt<DV>(vr, lds + VT);
    __syncthreads();
    if (MIX == 1) {
#pragma unroll
        for (int ks = 0; ks < 4; ++ks)
#pragma unroll
            for (int nt = 0; nt < NTW; ++nt) sf[ks][nt] = *(const bf16x8*)(ST + (size_t)(16 * (hv * NTW + nt) + l15) * 128 + 32 * ks + quad * 8);
    }
#pragma unroll
    for (int rep = 0; rep < 2; ++rep) {
        const int jb = w + 8 * rep;
        if (jb < 12) {
            int ipj, jt;
            if (jb >= 10) { ipj = (jb == 10) ? 0 : 2; jt = (jb == 10) ? 1 : 3; }
            else { ipj = jb >= 6 ? 3 : (jb >= 3 ? 2 : (jb >= 1 ? 1 : 0)); jt = jb - ipj * (ipj + 1) / 2; }
            f32x4 a = (f32x4){0.f, 0.f, 0.f, 0.f};
            if (jb < 10) {
                const int kho = KH0 + 4352 * (ipj * (ipj + 1) / 2);
#pragma unroll
                for (int ks = 0; ks < 4; ++ks) {
                    const bf16x8 qa = *(const LAS bf16x8*)(lds + QH + (16 * ipj + l15) * 272 + (32 * ks + quad * 8) * 2);
                    const bf16x8 kb = *(const LAS bf16x8*)(lds + kho + (16 * jt + l15) * 272 + (32 * ks + quad * 8) * 2);
                    a = MFMA16(qa, kb, a);
                }
                if (jt == ipj) {
#pragma unroll
                    for (int j = 0; j < 4; ++j) if (l15 > quad * 4 + j) a[j] = 0.f;
                }
            }
#pragma unroll
            for (int j = 0; j < 4; ++j) *(LAS bf16_t*)(lds + AB + (16 * ipj + quad * 4 + j) * 144 + (16 * jt + l15) * 2) = f2bf(a[j]);
        }
    }
    __syncthreads();
    f32x4 acc[NTW];
#pragma unroll
    for (int nt = 0; nt < NTW; ++nt) acc[nt] = (f32x4){0.f, 0.f, 0.f, 0.f};
#pragma unroll
    for (int ks = 0; ks < 4; ++ks) {
        const bf16x8 qa = *(const LAS bf16x8*)(lds + QT + (16 * ip + l15) * 272 + (32 * ks + quad * 8) * 2);
#pragma unroll
        for (int nt = 0; nt < NTW; ++nt) acc[nt] = MFMA16(sf[ks][nt], qa, acc[nt]);
    }
#pragma unroll
    for (int ks = 0; ks < 2; ++ks) {
        if (ks == 0 || ip >= 2) {
            const bf16x8 aa = *(const LAS bf16x8*)(lds + AB + (16 * ip + l15) * 144 + (32 * ks + quad * 8) * 2);
#pragma unroll
            for (int nt = 0; nt < NTW; ++nt) { const bf16x8 vb = *(const LAS bf16x8*)(lds + VT + (16 * (hv * NTW + nt) + l15) * 144 + (32 * ks + quad * 8) * 2); acc[nt] = MFMA16(vb, aa, acc[nt]); }
        }
    }
    LAS float* rowss = (LAS float*)(lds + RS);
    { float ss = 0.f;
#pragma unroll
      for (int nt = 0; nt < NTW; ++nt) ss += acc[nt][0] * acc[nt][0] + acc[nt][1] * acc[nt][1] + acc[nt][2] * acc[nt][2] + acc[nt][3] * acc[nt][3];
      ss += __shfl_xor(ss, 16); ss += __shfl_xor(ss, 32);
      if (quad == 0) rowss[hv * 64 + 16 * ip + l15] = ss; }
    __syncthreads();
    { const float tot = rowss[16 * ip + l15] + rowss[64 + 16 * ip + l15];
      const float rinv = rsqrtf(tot * (1.0f / DV) + 1e-6f);
      const size_t row = (size_t)(64 * n + 16 * ip + l15);
#pragma unroll
      for (int nt = 0; nt < NTW; ++nt) {
          const int vv0 = 16 * (hv * NTW + nt) + quad * 4;
          const u32x2 gw = gwv[nt];
          const f32x4 on = *(const f32x4*)(onorm + vv0);
          const float o0 = acc[nt][0] * rinv * on[0] * __uint_as_float(gw.x << 16), o1 = acc[nt][1] * rinv * on[1] * __uint_as_float(gw.x & 0xffff0000u);
          const float o2 = acc[nt][2] * rinv * on[2] * __uint_as_float(gw.y << 16), o3 = acc[nt][3] * rinv * on[3] * __uint_as_float(gw.y & 0xffff0000u);
          u32x2 yw; yw.x = cvt_pk_bf16(o0, o1); yw.y = cvt_pk_bf16(o2, o3);
          if (!dummy || o0 == 12345.678f) *(u32x2*)(Z + row * LDZ1 + vcol + vv0) = yw;
      } }
    __syncthreads();
}
template <int MIX>
__device__ __forceinline__ void scanA_loop(const Params& P, LAS unsigned char* lds, int bid, int nb) {
    constexpr int DV = MIX ? 256 : 128, NH = MIX ? 4 : 8, NU = 256 * NH;
    if (bid >= NU) return;
    const bf16_t* Z = (const bf16_t*)(P.ws + WS_Z);
    int hc = bid % NH;
    FrontC C; front_consts<MIX>(P, hc, C);
    float zn[16]; f32x4 gn = (f32x4){0.f, 0.f, 0.f, 0.f}; u32x4 vn[DV / 64];
    { const int n = bid / NH, h = bid % NH; front_load<MIX>(P, n, h, zn, gn); load_v<DV>(Z + (size_t)(64 * n) * LDZ1 + (MIX ? 6144 + h * 256 : 5120 + h * 128), vn); }
    for (int u = bid; u < NU; u += nb) {
        const int n = u / NH, h = u % NH;
        float zr[16]; u32x4 vr[DV / 64]; const f32x4 gq = gn;
#pragma unroll
        for (int t = 0; t < 16; ++t) zr[t] = zn[t];
#pragma unroll
        for (int t = 0; t < DV / 64; ++t) vr[t] = vn[t];
        const int un = u + nb;
        if (un < NU) { const int n2 = un / NH, h2 = un % NH; front_load<MIX>(P, n2, h2, zn, gn); load_v<DV>(Z + (size_t)(64 * n2) * LDZ1 + (MIX ? 6144 + h2 * 256 : 5120 + h2 * 128), vn); }
        if (h != hc) { hc = h; front_consts<MIX>(P, h, C); }
        scanA_unit<MIX>(P, lds, n, h, C, zr, gq, vr);
    }
}
__device__ __forceinline__ void phase_scanA(const Params& P, LAS unsigned char* lds, int bid, int nb) {
    scanA_loop<0>(P, lds, bid, nb);
    scanA_loop<1>(P, lds, bid, nb);
}
__device__ __forceinline__ void phase_scanC(const Params& P, LAS unsigned char* lds, int bid, int nb, bool dummy) {
    for (int u = bid; u < 3072; u += nb) { const int n = u / 12, hh = u % 12; if (hh < 8) scanC_unit<0>(P, lds, n, hh, dummy); else scanC_unit<1>(P, lds, n, hh - 8, dummy); }
}
__device__ __forceinline__ void phase_final(const Params& P, int bid, int nb) {
    const int tid = threadIdx.x, wid = tid >> 6, lane = tid & 63;
    const float* ss4 = (const float*)(P.ws + WS_STAT) + 7 * SEQ;
    const bf16_t* hb = (const bf16_t*)(P.ws + WS_HA);
    f32x4 g0[4], g1[4];
#pragma unroll
    for (int i = 0; i < 4; ++i) { const int c = lane * 8 + 512 * i; g0[i] = *(const f32x4*)(P.final_norm + c); g1[i] = *(const f32x4*)(P.final_norm + c + 4); }
    for (int row = bid * 32 + wid * 4; row < SEQ; row += nb * 32) {
        u32x4 hw[4][4]; float rinv[4];
#pragma unroll
        for (int q = 0; q < 4; ++q) {
            rinv[q] = ss4[row + q];
#pragma unroll
            for (int i = 0; i < 4; ++i) hw[q][i] = *(const u32x4*)(hb + (size_t)(row + q) * DM + lane * 8 + 512 * i);
        }
#pragma unroll
        for (int q = 0; q < 4; ++q) {
            const float ri = rsqrtf(rinv[q] * (1.f / 2048.f) + 1e-6f);
            float* orow = P.out + (size_t)(row + q) * DM;
#pragma unroll
            for (int i = 0; i < 4; ++i) {
                const int c = lane * 8 + 512 * i; const u32x4 w = hw[q][i];
                f32x4 o0, o1;
                o0[0] = __uint_as_float(w[0] << 16) * ri * g0[i][0]; o0[1] = __uint_as_float(w[0] & 0xffff0000u) * ri * g0[i][1];
                o0[2] = __uint_as_float(w[1] << 16) * ri * g0[i][2]; o0[3] = __uint_as_float(w[1] & 0xffff0000u) * ri * g0[i][3];
                o1[0] = __uint_as_float(w[2] << 16) * ri * g1[i][0]; o1[1] = __uint_as_float(w[2] & 0xffff0000u) * ri * g1[i][1];
                o1[2] = __uint_as_float(w[3] << 16) * ri * g1[i][2]; o1[3] = __uint_as_float(w[3] & 0xffff0000u) * ri * g1[i][3];
                *(f32x4*)(orow + c) = o0; *(f32x4*)(orow + c + 4) = o1;
            }
        }
    }
}

__device__ __forceinline__ void phase_glr(const Params& P, LAS unsigned char* lds, int bid, int nb) {
    const int tid = threadIdx.x, w = __builtin_amdgcn_readfirstlane(tid >> 6), lane = tid & 63, l15 = lane & 15, quad = lane >> 4;
    const bf16_t* A = (const bf16_t*)(P.ws + WS_HA);
    const bf16_t* Wt = (const bf16_t*)(P.ws + WS_WIN1) + (size_t)7168 * DM;
    const float* ss2 = (const float*)(P.ws + WS_STAT) + 4 * SEQ;
    float* glr = (float*)(P.ws + WS_GLR);
    LAS f32x4* part = (LAS f32x4*)lds;
    for (int g = bid; g < SEQ / 64; g += nb) {
        const int blk = w & 3, kh = w >> 2, r0 = 64 * g + 16 * blk;
        const bf16_t* ap = A + (size_t)(r0 + l15) * DM + kh * 1024 + quad * 8;
        const bf16_t* bp = Wt + (size_t)l15 * DM + kh * 1024 + quad * 8;
        f32x4 acc = (f32x4){0.f, 0.f, 0.f, 0.f};
#pragma unroll 8
        for (int ks = 0; ks < 32; ++ks) { const bf16x8 av = *(const bf16x8*)(ap + 32 * ks), bv = *(const bf16x8*)(bp + 32 * ks); acc = MFMA16(bv, av, acc); }
        if (kh == 1) part[blk * 64 + lane] = acc;
        __syncthreads();
        if (kh == 0) {
            const f32x4 o = acc + part[blk * 64 + lane];
            const float rs = rsqrtf(ss2[r0 + l15] * (1.f / 2048.f) + 1e-6f);
            *(f32x4*)(glr + (size_t)(r0 + l15) * 16 + quad * 4) = o * rs;
        }
        __syncthreads();
    }
}

template <int MODE>
__device__ __forceinline__ void run_gemm(LAS unsigned char* lds, const bf16_t* A, int lda, const bf16_t* Bt, int N, int K, const Epi<MODE>& E, int G, int c) {
    pg8::Gemm g; g.A = A; g.Bt = Bt; g.lda = lda; g.M = SEQ; g.N = N; g.K = K;
    pg8::StaticOrder S; S.init(SEQ, N, G, c);
    pg8::gemm_phase<Epi<MODE>>(lds, g, S, E);
}

#define XB_TMO      128
#define XB_XCNT(j)  (256  + 64 * (j))
#define XB_XSUB(j)  (1280 + 64 * (j))
#define XB_XGEN(j)  (2304 + 64 * (j))
#define XB_TOP      3328
#define XB_TOPGEN   3392
#define XCD_BAR_WORDS 3456
#define XB_SPIN_CAP (1u << 18)

__device__ __forceinline__ unsigned xb_ld(unsigned* p)              { return __hip_atomic_load(p, __ATOMIC_RELAXED, __HIP_MEMORY_SCOPE_AGENT); }
__device__ __forceinline__ unsigned xb_add(unsigned* p, unsigned v) { return __hip_atomic_fetch_add(p, v, __ATOMIC_RELAXED, __HIP_MEMORY_SCOPE_AGENT); }
__device__ __forceinline__ unsigned xb_xcc_id() { return (unsigned)__builtin_amdgcn_s_getreg((3 << 11) | 20) & 0xFu; }
#define XB_SPIN(cond, bar) do { unsigned _sp = 0; while (cond) { __builtin_amdgcn_s_sleep(1); \
    if ((++_sp & 255u) == 0u) { if (xb_ld(&(bar)[XB_TMO])) break; if (_sp > XB_SPIN_CAP) { atomicAdd(&(bar)[XB_TMO], 1u); break; } } } } while (0)

struct XcdBarrier {
    unsigned* bar; unsigned x;
    volatile LAS unsigned* st;
};

__device__ __forceinline__ XcdBarrier xcd_barrier_post(unsigned* bar, volatile LAS unsigned* st) {
    XcdBarrier b; b.bar = bar; b.x = xb_xcc_id(); b.st = st;
    if (threadIdx.x == 0) (void)xb_add(&bar[XB_XCNT(b.x)], 1u);
    return b;
}
__device__ __forceinline__ void xcd_barrier_complete(unsigned* bar, unsigned x, unsigned& nloc, unsigned& nx) {
    const unsigned G = gridDim.x * gridDim.y * gridDim.z;
    unsigned sum, cnt, mine, sp = 0u;
    for (;;) {
        sum = 0u; cnt = 0u; mine = 0u;
#pragma unroll
        for (unsigned j = 0; j < 16; ++j) { const unsigned c = xb_ld(&bar[XB_XCNT(j)]); sum += c; cnt += (c > 0u) ? 1u : 0u; mine = (j == x) ? c : mine; }
        if (sum == G) break;
        __builtin_amdgcn_s_sleep(1);
        if ((++sp & 255u) == 0u) { if (xb_ld(&bar[XB_TMO])) break; if (sp > XB_SPIN_CAP) { atomicAdd(&bar[XB_TMO], 1u); break; } }
    }
    nloc = mine > 0u ? mine : 1u; nx = cnt > 0u ? cnt : 1u;
}

__device__ __forceinline__ void xcd_barrier(const XcdBarrier& b) {
    asm volatile("s_waitcnt vmcnt(0)" ::: "memory");
    __syncthreads();
    if (threadIdx.x == 0) {
        unsigned* bar = b.bar;
        __builtin_amdgcn_s_waitcnt(0);
        unsigned nloc = b.st[0], nx = b.st[1];
        if (nloc == 0u) { xcd_barrier_complete(bar, b.x, nloc, nx); b.st[0] = nloc; b.st[1] = nx; }
        const unsigned old = xb_add(&bar[XB_XSUB(b.x)], 1u);
        const unsigned gen = old / nloc;
        if (old + 1u == (gen + 1u) * nloc) {
            __builtin_amdgcn_fence(__ATOMIC_RELEASE, "agent");
            asm volatile("s_waitcnt vmcnt(0)" ::: "memory");
            const unsigned og = xb_add(&bar[XB_TOP], 1u);
            const unsigned tg = og / nx;
            if (og + 1u == (tg + 1u) * nx) xb_add(&bar[XB_TOPGEN], 1u);
            else XB_SPIN(xb_ld(&bar[XB_TOPGEN]) == tg, bar);
            __builtin_amdgcn_fence(__ATOMIC_ACQUIRE, "agent");
            xb_add(&bar[XB_XGEN(b.x)], 1u);
            asm volatile("s_waitcnt vmcnt(0)" ::: "memory");
        } else {
            XB_SPIN(xb_ld(&bar[XB_XGEN(b.x)]) == gen, bar);
            __builtin_amdgcn_fence(__ATOMIC_ACQUIRE, "agent");
            asm volatile("s_waitcnt vmcnt(0)" ::: "memory");
        }
    }
    __syncthreads();
}


__device__ __forceinline__ void grid_bar(unsigned* ctr, unsigned target) {
    asm volatile("s_waitcnt vmcnt(0)" ::: "memory");
    __syncthreads();
    if (threadIdx.x == 0) {
        __builtin_amdgcn_fence(__ATOMIC_RELEASE, "agent");
        asm volatile("s_waitcnt vmcnt(0)" ::: "memory");
        __hip_atomic_fetch_add(ctr, 1u, __ATOMIC_RELAXED, __HIP_MEMORY_SCOPE_AGENT);
        while (__hip_atomic_load(ctr, __ATOMIC_RELAXED, __HIP_MEMORY_SCOPE_AGENT) < target) __builtin_amdgcn_s_sleep(2);
        __builtin_amdgcn_fence(__ATOMIC_ACQUIRE, "agent");
        asm volatile("s_waitcnt vmcnt(0)" ::: "memory");
    }
    __syncthreads();
}
__device__ __forceinline__ bool phase_begin(const Params& P, int k, const XcdBarrier& xb) {
    if (k < P.ph_lo || k >= P.ph_hi) return false;
    if (k > P.ph_lo) {
        if (P.ph_hi < 0) cg::this_grid().sync();
        xcd_barrier(xb);
    }
    return true;
}
template <int K>
__device__ __forceinline__ void run_phase(const Params& P, LAS unsigned char* lds, int bid, int nb, bool dummy) {
    unsigned char* ws = P.ws;
    float* stat = (float*)(ws + WS_STAT);
    float *ss0 = stat, *ssv = stat + SEQ, *ssE0 = stat + 2 * SEQ, *ss1 = stat + 3 * SEQ, *ss2 = stat + 4 * SEQ, *ss3 = stat + 5 * SEQ, *ssE1 = stat + 6 * SEQ, *ss4 = stat + 7 * SEQ, *ssD = stat + 8 * SEQ;
    bf16_t *HA = (bf16_t*)(ws + WS_HA), *HB = (bf16_t*)(ws + WS_HB), *Z = (bf16_t*)(ws + WS_Z), *E0 = (bf16_t*)(ws + WS_E0), *PBF = (bf16_t*)(ws + WS_PB);
    if (K == 0) phase_prep(P, lds, bid, nb);
    if (K == 1) {
        { Epi<1> E{}; E.o16 = Z; E.ld16 = LDZ0; E.ss_in = ss0; E.ss_out = dummy ? ssD : ssv; run_gemm<1>(lds, HA, DM, (const bf16_t*)(ws + WS_WIN0), 5376, 2048, E, nb, bid); }
        { const int skip = (nb == 256) ? 64 : 0;
          if (bid >= skip && !(DUP_PH == 101 && dummy)) { Epi<2> E{}; E.o16 = E0; E.ld16 = DM; E.ss_out = dummy ? ssD : ssE0; run_gemm<2>(lds, PBF, 256, (const bf16_t*)(ws + WS_WP0), 2048, 256, E, nb - skip, bid - skip);
            if (!dummy) phase_wconv(P, lds, 32 * 21 + 256 + 256 + 32, 32 * 21 + 256 + 256 + 32 + 32 * 29 + 256 + 256 + 32, bid - skip, nb - skip); } }
    }
    if (K == 2) phase_mix0(P, lds, bid, nb);
    if (K == 3) { Epi<3> E{}; E.o16 = HB; E.ld16 = DM; E.resid = P.x; E.ss_out = dummy ? ssD : ss1; run_gemm<3>(lds, HA, DM, (const bf16_t*)(ws + WS_WOUT0), 2048, 2048, E, nb, bid); }
    if (K == 4) { Epi<4> E{}; E.o16 = HA; E.ld16 = DM; E.resid16 = HB; E.ss_in = ss1; E.ss_out = ss2; E.E = E0; E.ssE = ssE0; E.pnorm = P.ple_norm; E.dummy = dummy; if (dummy) E.ss_out = ssD;
        run_gemm<4>(lds, HB, DM, (const bf16_t*)(ws + WS_WG0), 2048, 2048, E, nb, bid); }
    if (K == 5) { Epi<5> E{}; E.o16 = Z; E.ld16 = LDZ1; E.ss_in = ss2; E.glr = (float*)(ws + WS_GLR); E.dummy = (DUP_PH == 105) ? dummy : 0; run_gemm<5>(lds, HA, DM, (const bf16_t*)(ws + WS_WIN1), 7168, 2048, E, nb, bid); if (!(DUP_PH == 105 && dummy)) phase_glr(P, lds, bid, nb); }
    if (K == 6) phase_scanA(P, lds, bid, nb);
    if (K == 7) phase_scanB(P, lds, bid, nb);
    if (K == 8) phase_scanC(P, lds, bid, nb, dummy);
    if (K == 9) {
        { Epi<3> E{}; E.o16 = HB; E.ld16 = DM; E.resid16 = HA; E.ss_out = ss3; run_gemm<3>(lds, Z + 5120, LDZ1, (const bf16_t*)(ws + WS_WOUT1), 2048, 2048, E, nb, bid); }
        { Epi<2> E{}; E.o16 = (bf16_t*)P.out; E.ld16 = DM; E.ss_out = ssE1; run_gemm<2>(lds, PBF + (size_t)SEQ * 256, 256, (const bf16_t*)(ws + WS_WP1), 2048, 256, E, nb, bid); }
    }
    if (K == 10) { Epi<4> E{}; E.o16 = HA; E.ld16 = DM; E.resid16 = HB; E.ss_in = ss3; E.ss_out = ss4; E.E = (const bf16_t*)P.out; E.ssE = ssE1; E.pnorm = P.ple_norm + DM; E.dummy = dummy; if (dummy) E.ss_out = ssD;
        run_gemm<4>(lds, HB, DM, (const bf16_t*)(ws + WS_WG1), 2048, 2048, E, nb, bid); }
    if (K == 11) phase_final(P, bid, nb);
}
#define PHASE(k) do { if ((ONLY_PH < 0 || ONLY_PH == (k)) && phase_begin(P, (k), xb)) { \
        if (DUP_PH == (k) || (DUP_PH == 101 && (k) == 1) || (DUP_PH == 105 && (k) == 5)) { run_phase<(k)>(P, lds, bid, nb, true); cg::this_grid().sync(); } \
        run_phase<(k)>(P, lds, bid, nb, false); \
        if (DUP_PH == 67 && (k) == 7) { cg::this_grid().sync(); run_phase<6>(P, lds, bid, nb, false); cg::this_grid().sync(); run_phase<7>(P, lds, bid, nb, false); } \
        if (DUP_PH == 5678 && (k) == 8) { cg::this_grid().sync(); run_phase<5>(P, lds, bid, nb, false); cg::this_grid().sync(); run_phase<6>(P, lds, bid, nb, false); cg::this_grid().sync(); run_phase<7>(P, lds, bid, nb, false); cg::this_grid().sync(); run_phase<8>(P, lds, bid, nb, false); } \
        } } while (0)
__global__ void __launch_bounds__(512, 2) mega(Params P) {
    extern __shared__ __attribute__((aligned(16))) unsigned char shm[];
    LAS unsigned char* lds = (LAS unsigned char*)shm;
    const int bid = blockIdx.x, nb = gridDim.x;
    volatile LAS unsigned* xst = (volatile LAS unsigned*)(lds + 131072);
    if (threadIdx.x == 0) { xst[0] = 0u; xst[1] = 0u; }
    __syncthreads();
    XcdBarrier xb = xcd_barrier_post((unsigned*)(P.ws + WS_BAR), xst);
    PHASE(0); PHASE(1);
#if DUP_PH == 100
    for (int q = 0; q < 20; ++q) grid_bar((unsigned*)(P.ws + WS_BAR) + 32, (unsigned)(q + 1) * gridDim.x);
#endif
 PHASE(2); PHASE(3); PHASE(4); PHASE(5); PHASE(6); PHASE(7); PHASE(8); PHASE(9); PHASE(10); PHASE(11);
}

extern "C" void kernel_launch(void* const* d_in, const int* in_sizes, int n_in, void* d_out, int out_size, void* d_ws, size_t ws_size, hipStream_t stream) {
    static int grid = 0;
    if (grid == 0) {
        if (n_in != 21 || out_size != SEQ * DM || ws_size < WS_END) { fprintf(stderr, "kernel_launch: unexpected shapes (n_in %d out %d ws %zu need %zu)\n", n_in, out_size, ws_size, (size_t)WS_END); grid = -1; return; }
        int dev = 0, cus = 0, per_cu = 0;
        hipGetDevice(&dev);
        hipDeviceGetAttribute(&cus, hipDeviceAttributeMultiprocessorCount, dev);
        if (hipFuncSetAttribute((const void*)mega, hipFuncAttributeMaxDynamicSharedMemorySize, LDS_BYTES) != hipSuccess) { fprintf(stderr, "kernel_launch: hipFuncSetAttribute failed\n"); grid = -1; return; }
        if (hipOccupancyMaxActiveBlocksPerMultiprocessor(&per_cu, (const void*)mega, 512, LDS_BYTES) != hipSuccess || per_cu < 1) { fprintf(stderr, "kernel_launch: occupancy query says %d\n", per_cu); per_cu = 1; }
        (void)hipGetLastError();
        grid = cus * 1;
    }
    if (grid < 0) return;
    Params P{};
    const float** pp = (const float**)&P;
    for (int i = 0; i < 21; ++i) pp[i] = (const float*)d_in[i];
    P.out = (float*)d_out; P.ws = (unsigned char*)d_ws;
#if ONE_LAUNCH
    P.ph_lo = 0; P.ph_hi = NPH;
    if (hipMemsetAsync((unsigned char*)d_ws + WS_BAR, 0, 16384, stream) != hipSuccess) { fprintf(stderr, "kernel_launch: memset of barrier words failed\n"); return; }
    void* args[] = {&P};
    hipError_t e = hipLaunchCooperativeKernel((const void*)mega, dim3(grid), dim3(512), args, LDS_BYTES, stream);
    if (e != hipSuccess) fprintf(stderr, "cooperative launch failed: %s (grid %d)\n", hipGetErrorString(e), grid);
#else
    for (int ph = 0; ph < NPH; ++ph) { P.ph_lo = ph; P.ph_hi = ph + 1; hipLaunchKernelGGL(mega, dim3(grid), dim3(512), LDS_BYTES, stream, P); }
#endif
}
```

```cpp
#include <hip/hip_runtime.h>
#include <hip/hip_cooperative_groups.h>
#include <cstdio>
namespace cg = cooperative_groups;

#ifndef ONE_LAUNCH
#define ONE_LAUNCH 1
#endif

#ifndef DUP_PH
#define DUP_PH -1
#endif
#ifndef ONLY_PH
#define ONLY_PH -1
#endif
#define LAS __attribute__((address_space(3)))
typedef unsigned short bf16_t;
typedef short bf16x8 __attribute__((ext_vector_type(8)));
typedef float f32x4 __attribute__((ext_vector_type(4)));
typedef float f32x2 __attribute__((ext_vector_type(2)));
typedef unsigned u32x4 __attribute__((ext_vector_type(4)));
typedef unsigned u32x2 __attribute__((ext_vector_type(2)));

constexpr int SEQ = 16384, DM = 2048;
constexpr int LDZ0 = 5376, LDZ1 = 7424;
constexpr int NPH = 12;
constexpr int LDS_BYTES = 131072 + 16;

constexpr size_t SZ_WIN0 = (size_t)5376 * 2048 * 2, SZ_W2K = (size_t)2048 * 2048 * 2, SZ_WP = (size_t)2048 * 256 * 2, SZ_WIN1 = (size_t)7424 * 2048 * 2;
constexpr size_t WS_WIN0 = 0, WS_WOUT0 = WS_WIN0 + SZ_WIN0, WS_WG0 = WS_WOUT0 + SZ_W2K, WS_WP0 = WS_WG0 + SZ_W2K;
constexpr size_t WS_WIN1 = WS_WP0 + SZ_WP, WS_WOUT1 = WS_WIN1 + SZ_WIN1, WS_WG1 = WS_WOUT1 + SZ_W2K, WS_WP1 = WS_WG1 + SZ_W2K;
constexpr size_t WS_PB = WS_WP1 + SZ_WP;
constexpr size_t WS_HA = WS_PB + (size_t)2 * SEQ * 256 * 2;
constexpr size_t WS_HB = WS_HA + (size_t)SEQ * DM * 2;
constexpr size_t WS_Z = WS_HB + (size_t)SEQ * DM * 2;
constexpr size_t WS_E0 = WS_Z + (size_t)SEQ * LDZ0 * 2;
constexpr size_t WS_STAT = WS_Z + (size_t)SEQ * LDZ1 * 2;
constexpr size_t WS_GLR = WS_STAT + (size_t)9 * SEQ * 4;
constexpr size_t WS_DBUF = WS_GLR + (size_t)SEQ * 16 * 4;
constexpr size_t WS_BAR = WS_DBUF + (size_t)256 * 1536 * 4;
constexpr size_t WS_END = WS_BAR + 16384;

struct Params {
    const float *x, *p, *norm_mix, *w_in_even, *sinks, *vnorm, *w_sp, *b_sp, *w_out_even, *w_in_odd, *lower_bounds, *onorm_c, *w_gate_up, *b_gate, *onorm_d,
        *w_out_odd, *w_ple_proj, *ple_norm, *ple_gate_norm, *w_ple_gate, *final_norm;
    float* out; unsigned char* ws; int ph_lo, ph_hi;
};

__device__ __forceinline__ float bf2f(bf16_t b) { return __uint_as_float(((unsigned)b) << 16); }
typedef __bf16 bf16v2_t __attribute__((ext_vector_type(2)));
__device__ __forceinline__ unsigned cvt_pk_bf16(float lo, float hi) { const f32x2 v = (f32x2){lo, hi}; const bf16v2_t r = __builtin_convertvector(v, bf16v2_t); return __builtin_bit_cast(unsigned, r); }
__device__ __forceinline__ bf16_t f2bf(float f) { return (bf16_t)(cvt_pk_bf16(f, 0.f) & 0xffffu); }
__device__ __forceinline__ float fast_sigmoid(float x) { return __builtin_amdgcn_rcpf(1.0f + __builtin_amdgcn_exp2f(-1.44269504f * x)); }
__device__ __forceinline__ float silu_f(float x) { return x * fast_sigmoid(x); }
__device__ __forceinline__ f32x2 gelu_pk(f32x2 v) {
    const f32x2 av = __builtin_elementwise_abs(v), d = av * 0.2316418882f + 1.0f;
    f32x2 t; t.x = __builtin_amdgcn_rcpf(d.x); t.y = __builtin_amdgcn_rcpf(d.y);
    f32x2 q = t * 0.5307027145f + (-0.7265760135f); q = q * t + 0.7107068705f; q = q * t + (-0.142248368f); q = q * t + 0.127414796f; q = q * t;
    const f32x2 s = (v * v) * (-0.72134752044f);
    f32x2 e; e.x = __builtin_amdgcn_exp2f(s.x); e.y = __builtin_amdgcn_exp2f(s.y);
    const f32x2 m = v * (q * e), r = v - m;
    f32x2 o; o.x = v.x < 0.f ? m.x : r.x; o.y = v.y < 0.f ? m.y : r.y; return o;
}
#define MFMA16(a, b, c) __builtin_amdgcn_mfma_f32_16x16x32_bf16((a), (b), (c), 0, 0, 0)

namespace pg8 {
constexpr int BM = 256, BK = 64, HALF = 128, HTB = HALF * BK * 2, NXCD = 8, WGM = 8;
__host__ __device__ __forceinline__ int lds_byte(int r, int c) { const int st = (r >> 4) * 2 + (c >> 5), rr = r & 15, cc = c & 31, ob = rr * 64 + cc * 2; return st * 1024 + (ob ^ (((ob >> 9) & 1) << 5)); }
__host__ __device__ __forceinline__ void stage_rc(int b, int& R, int& C) { const int st = b / 1024, sb = b % 1024, swz = sb ^ (((sb >> 9) & 1) << 5); R = (st >> 1) * 16 + swz / 64; C = (st & 1) * 32 + (swz % 64) / 2; }
__host__ __device__ __forceinline__ int perm32(int rho) { const int n = rho >> 4, i = rho & 15; return 8 * (i >> 2) + 4 * n + (i & 3); }
struct Unit { int pm, pn; };
struct Gemm { const bf16_t* A; const bf16_t* Bt; int lda, M, N, K; };
struct StaticOrder {
    int nM, nN, nwg, G, c;
    __device__ void init(int M, int N, int G_, int c_) { nM = M / BM; nN = N / BM; nwg = nM * nN; G = G_; c = c_; }
    __device__ bool next(int i, Unit& u) const {
        const long L = (long)i * G + c; if (L >= nwg) return false;
        int wgid = (int)L; { const int q = nwg / NXCD, r = nwg % NXCD, xcd = wgid % NXCD, off = wgid / NXCD; wgid = (xcd < r ? xcd * (q + 1) : r * (q + 1) + (xcd - r) * q) + off; }
        const int nig = WGM * nN, gid = wgid / nig, fm = gid * WGM, gsz = (nM - fm) < WGM ? (nM - fm) : WGM;
        u.pm = fm + ((wgid % nig) % gsz); u.pn = (wgid % nig) / gsz; return true;
    }
};

template <class Epi>
__device__ __forceinline__ void gemm_phase(LAS unsigned char* lds, const Gemm g, const StaticOrder& S, const Epi& E) {
    const int tid = threadIdx.x, wid = __builtin_amdgcn_readfirstlane(tid >> 6), lane = tid & 63, wr = wid >> 2, wc = wid & 3, fr = lane & 15, fq = lane >> 4;
    int K = g.K; asm volatile("" : "+s"(K)); const int nt = K / BK, lda = g.lda;
    unsigned voffA[2], voffB[2];
#pragma unroll
    for (int i = 0; i < 2; ++i) { int R, C; stage_rc(tid * 16 + i * 8192, R, C); const int Rb = Epi::PERM ? ((R & ~31) + perm32(R & 31)) : R;
        voffA[i] = (unsigned)(R * lda + C) * 2u; voffB[i] = (unsigned)(Rb * K + C) * 2u; }
    const size_t kstep = (size_t)(BK * 2);
    const size_t hstepA = (size_t)HALF * lda * 2, hstepB = (size_t)HALF * K * 2;
    const size_t tstepA = 2 * hstepA, tstepB = 2 * hstepB;
    const unsigned ldsw = (unsigned)wid * 1024u;
    const int aoff = lds_byte(wr * 64 + fr, fq * 8), boff = lds_byte(wc * 32 + fr, fq * 8);
#define PG8_SA(b, h) (((b) * 2 + (h)) * HTB)
#define PG8_SB(b, h) ((4 + (b) * 2 + (h)) * HTB)
#define PG8_STAGE(bufoff, gbase, voff) do { _Pragma("unroll") for (int _i = 0; _i < 2; ++_i) \
        __builtin_amdgcn_global_load_lds((const unsigned*)((const char*)(gbase) + (voff)[_i]), (LAS unsigned*)(lds + (bufoff) + ldsw + _i * 8192), 16, 0, 0); } while (0)
#define PG8_LDA(dst, b, h) do { _Pragma("unroll") for (int m = 0; m < 4; ++m) _Pragma("unroll") for (int k = 0; k < 2; ++k) dst[m][k] = *(const LAS bf16x8*)(lds + PG8_SA(b, h) + aoff + m * 2048 + k * 1024); } while (0)
#define PG8_LDB(dst, b, h) do { _Pragma("unroll") for (int n = 0; n < 2; ++n) _Pragma("unroll") for (int k = 0; k < 2; ++k) dst[n][k] = *(const LAS bf16x8*)(lds + PG8_SB(b, h) + boff + n * 2048 + k * 1024); } while (0)
#define PG8_MMA(ai, bj, At, Bt) do { __builtin_amdgcn_s_setprio(1); _Pragma("unroll") for (int m = 0; m < 4; ++m) _Pragma("unroll") for (int n = 0; n < 2; ++n) _Pragma("unroll") for (int k = 0; k < 2; ++k) \
        acc[ai][bj][m][n] = __builtin_amdgcn_mfma_f32_16x16x32_bf16(Bt[n][k], At[m][k], acc[ai][bj][m][n], 0, 0, 0); __builtin_amdgcn_s_setprio(0); } while (0)
#define PG8_WAIT_V(n) asm volatile("s_waitcnt vmcnt(" #n ")" ::: "memory")
#define PG8_WAIT_L(n) asm volatile("s_waitcnt lgkmcnt(" #n ")" ::: "memory")
#define PG8_BAR __builtin_amdgcn_s_barrier()
#define PG8_SCHED __builtin_amdgcn_sched_barrier(0)
    Unit cur, nxt, pu; int ui = 0;
    if (!S.next(0, cur)) return;
    pu = cur; float psum[8] = {0.f, 0.f, 0.f, 0.f, 0.f, 0.f, 0.f, 0.f}; bool pend = false;
    f32x4 acc[2][2][4][2];
#pragma unroll
    for (int a = 0; a < 2; ++a)
#pragma unroll
        for (int b = 0; b < 2; ++b)
#pragma unroll
            for (int m = 0; m < 4; ++m)
#pragma unroll
                for (int n = 0; n < 2; ++n) acc[a][b][m][n] = (f32x4){0.f, 0.f, 0.f, 0.f};
    bf16x8 At[4][2], B0[2][2], B1[2][2];
    const char* cA = (const char*)g.A + (size_t)cur.pm * tstepA; const char* cB = (const char*)g.Bt + (size_t)cur.pn * tstepB;
    PG8_STAGE(PG8_SB(0, 0), cB, voffB); PG8_STAGE(PG8_SA(0, 0), cA, voffA); PG8_STAGE(PG8_SB(0, 1), cB + hstepB, voffB); PG8_STAGE(PG8_SA(0, 1), cA + hstepA, voffA);
    if (wr == 1) PG8_BAR;
    PG8_WAIT_V(4); PG8_BAR;
    PG8_STAGE(PG8_SB(1, 0), cB + kstep, voffB); PG8_STAGE(PG8_SA(1, 0), cA + kstep, voffA); PG8_STAGE(PG8_SB(1, 1), cB + hstepB + kstep, voffB);
    PG8_WAIT_V(6); PG8_BAR;
    for (;;) {
        const bool has_next = S.next(ui + 1, nxt);
        const char* nA = has_next ? (const char*)g.A + (size_t)nxt.pm * tstepA : cA; const char* nB = has_next ? (const char*)g.Bt + (size_t)nxt.pn * tstepB : cB;
#pragma clang loop unroll(disable)
        for (int t = 0; t < nt; t += 2) {
            const bool last = (t == nt - 2);
            if (pend && t == 2) { E.flush(psum, pu, wr, fr, fq); pend = false; }
            const char* a1 = cA + (size_t)(t + 1) * kstep;
            const char* a2 = last ? nA : cA + (size_t)(t + 2) * kstep; const char* b2 = last ? nB : cB + (size_t)(t + 2) * kstep;
            const char* a3 = a2 + kstep; const char* b3 = b2 + kstep;
            PG8_LDB(B0, 0, 0); PG8_SCHED; PG8_LDA(At, 0, 0); PG8_STAGE(PG8_SA(1, 1), a1 + hstepA, voffA);
            PG8_WAIT_L(8); PG8_BAR; PG8_WAIT_L(0); PG8_MMA(0, 0, At, B0); PG8_BAR; PG8_SCHED;
            PG8_LDB(B1, 0, 1); PG8_STAGE(PG8_SB(0, 0), b2, voffB);
            PG8_BAR; PG8_WAIT_L(0); PG8_MMA(0, 1, At, B1); PG8_BAR;
            PG8_LDA(At, 0, 1); PG8_STAGE(PG8_SA(0, 0), a2, voffA);
            PG8_BAR; PG8_WAIT_L(0); PG8_MMA(1, 0, At, B0); PG8_BAR; PG8_SCHED;
            PG8_STAGE(PG8_SB(0, 1), b2 + hstepB, voffB);
            PG8_WAIT_V(6); PG8_BAR; PG8_MMA(1, 1, At, B1); PG8_BAR;
            PG8_LDB(B0, 1, 0); PG8_SCHED; PG8_LDA(At, 1, 0); PG8_STAGE(PG8_SA(0, 1), a2 + hstepA, voffA);
            PG8_WAIT_L(8); PG8_BAR; PG8_WAIT_L(0); PG8_MMA(0, 0, At, B0); PG8_BAR; PG8_SCHED;
            PG8_LDB(B1, 1, 1); PG8_STAGE(PG8_SB(1, 0), b3, voffB);
            PG8_BAR; PG8_WAIT_L(0); PG8_MMA(0, 1, At, B1); PG8_BAR;
            PG8_LDA(At, 1, 1); PG8_STAGE(PG8_SA(1, 0), a3, voffA);
            PG8_BAR; PG8_WAIT_L(0); PG8_MMA(1, 0, At, B0); PG8_BAR; PG8_SCHED;
            PG8_STAGE(PG8_SB(1, 1), b3 + hstepB, voffB);
            PG8_WAIT_V(6); PG8_BAR; PG8_MMA(1, 1, At, B1); PG8_BAR;
        }
        pend = E(acc, cur, wr, wc, fr, fq, psum); pu = cur;
        if (!has_next) { if (pend) E.flush(psum, pu, wr, fr, fq); break; }
#pragma unroll
        for (int a = 0; a < 2; ++a)
#pragma unroll
            for (int b = 0; b < 2; ++b)
#pragma unroll
                for (int m = 0; m < 4; ++m)
#pragma unroll
                    for (int n = 0; n < 2; ++n) acc[a][b][m][n] = (f32x4){0.f, 0.f, 0.f, 0.f};
        cur = nxt; cA = nA; cB = nB; ++ui;
    }
    PG8_WAIT_V(0);
    if (wr == 0) PG8_BAR;
    PG8_BAR;
#undef PG8_SA
#undef PG8_SB
#undef PG8_STAGE
#undef PG8_LDA
#undef PG8_LDB
#undef PG8_MMA
#undef PG8_WAIT_V
#undef PG8_WAIT_L
#undef PG8_BAR
#undef PG8_SCHED
}
}

template <int MODE> struct Epi {
    static constexpr bool PERM = true;
    bf16_t* o16; int ld16; float* H; const float* resid; const float* ss_in; float* ss_out; const bf16_t* E; const float* ssE; const float* pnorm; float* glr; int dummy; const bf16_t* resid16;
    __device__ __forceinline__ void flush(const float (&sums)[8], const pg8::Unit& u, int wr, int fr, int fq) const {
        if (fq == 0) {
#pragma unroll
            for (int q = 0; q < 8; ++q) atomicAdd(ss_out + u.pm * 256 + wr * 64 + fr + (q >> 2) * 128 + (q & 3) * 16, sums[q]);
        }
    }
    __device__ __forceinline__ bool operator()(const f32x4 (&acc)[2][2][4][2], const pg8::Unit& u, int wr, int wc, int fr, int fq, float (&sums)[8]) const {
        const int row0 = u.pm * 256 + wr * 64 + fr, col0 = u.pn * 256 + wc * 32 + 8 * fq;
        int kind = 0;
        if (MODE == 1) { const int pn = u.pn; kind = pn < 4 ? 0 : (pn == 4 ? 1 : (pn < 9 ? 2 : (pn < 13 ? 3 : (pn < 17 ? 4 : 2)))); }
        if (MODE == 5) { const int pn = u.pn; kind = ((pn >= 8 && pn < 12) || (pn >= 16 && pn < 20)) ? 2 : 1; }
        float rsv[2][4], rEv[2][4];
#pragma unroll
        for (int ai = 0; ai < 2; ++ai)
#pragma unroll
            for (int m = 0; m < 4; ++m) {
                const int row = row0 + ai * 128 + m * 16;
                rsv[ai][m] = (MODE == 1 || MODE == 4 || MODE == 5) ? ss_in[row] : 0.f;
                rEv[ai][m] = (MODE == 4) ? ssE[row] : 0.f;
            }
        f32x4 pnv[2][2];
        if (MODE == 4) {
#pragma unroll
            for (int bj = 0; bj < 2; ++bj) { pnv[bj][0] = *(const f32x4*)(pnorm + col0 + bj * 128); pnv[bj][1] = *(const f32x4*)(pnorm + col0 + bj * 128 + 4); }
        }
#pragma unroll
        for (int ai = 0; ai < 2; ++ai)
#pragma unroll
            for (int m = 0; m < 4; ++m) { rsv[ai][m] = rsqrtf(rsv[ai][m] * (1.f / 2048.f) + 1e-6f); rEv[ai][m] = rsqrtf(rEv[ai][m] * (1.f / 2048.f) + 1e-6f); }
#pragma unroll
        for (int ai = 0; ai < 2; ++ai)
#pragma unroll
        for (int mh = 0; mh < 2; ++mh) {
            u32x4 rw[4][2], ew[4][2]; f32x4 rf[4][2][2];
            if (MODE == 3 || MODE == 4) {
#pragma unroll
                for (int m = 2 * mh; m < 2 * mh + 2; ++m)
#pragma unroll
                    for (int bj = 0; bj < 2; ++bj) {
                        const size_t off = (size_t)(row0 + ai * 128 + m * 16) * DM + col0 + bj * 128;
                        if (MODE == 4) { rw[m][bj] = *(const u32x4*)(resid16 + off); ew[m][bj] = *(const u32x4*)(E + off); }
                        if (MODE == 3) {
                            if (resid16 != nullptr) rw[m][bj] = *(const u32x4*)(resid16 + off);
                            else { rf[m][bj][0] = *(const f32x4*)(resid + off); rf[m][bj][1] = *(const f32x4*)(resid + off + 4); }
                        }
                    }
            }
#pragma unroll
            for (int m = 2 * mh; m < 2 * mh + 2; ++m) {
                const int row = row0 + ai * 128 + m * 16;
                const float rs = rsv[ai][m], rE = rEv[ai][m];
                float ssq = 0.f;
#pragma unroll
                for (int bj = 0; bj < 2; ++bj) {
                    const int col = col0 + bj * 128;
                    const f32x4 a0 = acc[ai][bj][m][0], a1 = acc[ai][bj][m][1];
                    float v[8] = {a0[0], a0[1], a0[2], a0[3], a1[0], a1[1], a1[2], a1[3]};
                    if (MODE == 1) {
#pragma unroll
                        for (int e = 0; e < 8; ++e) v[e] *= rs;
                        if (kind == 0) {
#pragma unroll
                            for (int e = 0; e < 8; ++e) v[e] *= 0.125f;
                        } else if (kind == 2) {
#pragma unroll
                            for (int e = 0; e < 8; ++e) v[e] = silu_f(v[e]);
                        } else if (kind >= 3) {
#pragma unroll
                            for (int e = 0; e < 8; e += 2) { f32x2 r = gelu_pk((f32x2){v[e], v[e + 1]}); v[e] = r.x; v[e + 1] = r.y; }
                            if (kind == 4) {
#pragma unroll
                                for (int e = 0; e < 8; ++e) ssq += v[e] * v[e];
                            }
                        }
                    }
                    if (MODE == 2) {
#pragma unroll
                        for (int e = 0; e < 8; ++e) ssq += v[e] * v[e];
                    }
                    if (MODE == 3) {
                        if (resid16 != nullptr) {
#pragma unroll
                            for (int e = 0; e < 4; ++e) { v[2 * e] += __uint_as_float(rw[m][bj][e] << 16); v[2 * e + 1] += __uint_as_float(rw[m][bj][e] & 0xffff0000u); }
                        } else {
#pragma unroll
                            for (int e = 0; e < 4; ++e) { v[e] += rf[m][bj][0][e]; v[e + 4] += rf[m][bj][1][e]; }
                        }
#pragma unroll
                        for (int e = 0; e < 8; ++e) ssq += v[e] * v[e];
                    }
                    if (MODE == 4) {
                        const float nv[8] = {pnv[bj][0][0], pnv[bj][0][1], pnv[bj][0][2], pnv[bj][0][3], pnv[bj][1][0], pnv[bj][1][1], pnv[bj][1][2], pnv[bj][1][3]};
#pragma unroll
                        for (int e = 0; e < 8; ++e) {
                            const float hv = (e & 1) ? __uint_as_float(rw[m][bj][e >> 1] & 0xffff0000u) : __uint_as_float(rw[m][bj][e >> 1] << 16);
                            const float evv = (e & 1) ? __uint_as_float(ew[m][bj][e >> 1] & 0xffff0000u) : __uint_as_float(ew[m][bj][e >> 1] << 16);
                            const float gte = fast_sigmoid(v[e] * rs); v[e] = hv + evv * rE * nv[e] * gte; ssq += v[e] * v[e]; }
                    }
                    if (MODE == 5) {
#pragma unroll
                        for (int e = 0; e < 8; ++e) v[e] *= rs;
                        if (kind == 2) {
#pragma unroll
                            for (int e = 0; e < 8; ++e) v[e] = silu_f(v[e]);
                        }
                    }
                    if (!dummy || v[0] == 12345.678f) {
                        u32x4 w; w.x = cvt_pk_bf16(v[0], v[1]); w.y = cvt_pk_bf16(v[2], v[3]); w.z = cvt_pk_bf16(v[4], v[5]); w.w = cvt_pk_bf16(v[6], v[7]);
                        *(u32x4*)(o16 + (size_t)row * ld16 + col) = w;
                    }
                }
                if (MODE == 2 || MODE == 3 || MODE == 4 || (MODE == 1 && kind == 4)) {
                    ssq += __shfl_xor(ssq, 16); ssq += __shfl_xor(ssq, 32);
                    sums[ai * 4 + m] = ssq;
                }
            }
        }
        return (MODE == 2 || MODE == 3 || MODE == 4 || (MODE == 1 && kind == 4));
    }
};

__device__ __forceinline__ int map_in1(int n) {
    if (n < 2048) return n;
    if (n < 4096) return n + 1024;
    if (n < 5120) return n + 2064;
    if (n < 6144) return n - 3072;
    if (n < 7184) return n - 1024;
    return -1;
}
__device__ __forceinline__ void wtrans_tile(const float* W, int K, int Nsrc, bf16_t* Wt, const float* gain, int mapk, int tk, int tn, LAS float* tl) {
    const int tid = threadIdx.x, tx = tid & 255, ty = tid >> 8;
    const int k0 = tk * 64, n0 = tn * 256;
    int sc = n0 + tx; if (mapk) sc = map_in1(sc);
    float v[32];
#pragma unroll
    for (int i = 0; i < 32; ++i) { const int kk = ty + 2 * i; v[i] = (sc >= 0) ? __builtin_nontemporal_load(W + (size_t)(k0 + kk) * Nsrc + sc) : 0.f; }
    if (gain) {
#pragma unroll
        for (int i = 0; i < 32; ++i) v[i] *= gain[k0 + ty + 2 * i];
    }
#pragma unroll
    for (int i = 0; i < 32; ++i) tl[(ty + 2 * i) * 257 + tx] = v[i];
    __syncthreads();
#pragma unroll
    for (int p = 0; p < 4; ++p) {
        const int n = p * 64 + (tid >> 3), seg = (tid & 7) * 8; float o[8];
#pragma unroll
        for (int j = 0; j < 8; ++j) o[j] = tl[(seg + j) * 257 + n];
        u32x4 w; w.x = cvt_pk_bf16(o[0], o[1]); w.y = cvt_pk_bf16(o[2], o[3]); w.z = cvt_pk_bf16(o[4], o[5]); w.w = cvt_pk_bf16(o[6], o[7]);
        *(u32x4*)(Wt + (size_t)(n0 + n) * K + k0 + seg) = w;
    }
    __syncthreads();
}
__device__ __forceinline__ void phase_wconv(const Params& P, LAS unsigned char* lds, int gbeg, int gend, int bid, int nb);
__device__ __forceinline__ void phase_prep(const Params& P, LAS unsigned char* lds, int bid, int nb) {
    const int tid = threadIdx.x, wid = tid >> 6, lane = tid & 63;
    unsigned char* ws = P.ws;
    float* stat = (float*)(ws + WS_STAT);
    for (int i = bid * 512 + tid; i < 7 * SEQ; i += nb * 512) stat[SEQ + i] = 0.f;
    { bf16_t* xb = (bf16_t*)(ws + WS_HA);
      for (int row = bid * 16 + wid * 2; row < SEQ; row += nb * 16) {
          const float* xr = P.x + (size_t)row * DM; float s0 = 0.f, s1 = 0.f;
          f32x4 va[8], vb[8];
#pragma unroll
          for (int i = 0; i < 8; ++i) { va[i] = __builtin_nontemporal_load((const f32x4*)(xr + lane * 4 + 256 * i)); vb[i] = __builtin_nontemporal_load((const f32x4*)(xr + DM + lane * 4 + 256 * i)); }
#pragma unroll
          for (int i = 0; i < 8; ++i) {
              s0 += va[i][0] * va[i][0] + va[i][1] * va[i][1] + va[i][2] * va[i][2] + va[i][3] * va[i][3];
              s1 += vb[i][0] * vb[i][0] + vb[i][1] * vb[i][1] + vb[i][2] * vb[i][2] + vb[i][3] * vb[i][3];
              u32x2 w; w.x = cvt_pk_bf16(va[i][0], va[i][1]); w.y = cvt_pk_bf16(va[i][2], va[i][3]); *(u32x2*)(xb + (size_t)row * DM + lane * 4 + 256 * i) = w;
              u32x2 w2; w2.x = cvt_pk_bf16(vb[i][0], vb[i][1]); w2.y = cvt_pk_bf16(vb[i][2], vb[i][3]); *(u32x2*)(xb + (size_t)(row + 1) * DM + lane * 4 + 256 * i) = w2; }
#pragma unroll
          for (int o = 1; o < 64; o <<= 1) { s0 += __shfl_xor(s0, o); s1 += __shfl_xor(s1, o); }
          if (lane == 0) { stat[row] = s0; stat[row + 1] = s1; }
      } }
    { bf16_t* pb = (bf16_t*)(ws + WS_PB);
      const size_t total = (size_t)2 * SEQ * 256, stride = (size_t)nb * 512 * 4;
      for (size_t i0 = (size_t)(bid * 512 + tid) * 4; i0 < total; i0 += stride * 8) {
          f32x4 v[8];
#pragma unroll
          for (int q = 0; q < 8; ++q) { const size_t i = i0 + stride * q; v[q] = (i < total) ? __builtin_nontemporal_load((const f32x4*)(P.p + i)) : (f32x4){0.f, 0.f, 0.f, 0.f}; }
#pragma unroll
          for (int q = 0; q < 8; ++q) { const size_t i = i0 + stride * q; if (i < total) { u32x2 w; w.x = cvt_pk_bf16(v[q][0], v[q][1]); w.y = cvt_pk_bf16(v[q][2], v[q][3]); *(u32x2*)(pb + i) = w; } }
      } }
    phase_wconv(P, lds, 0, 32 * 21 + 256 + 256 + 32, bid, nb);
}
__device__ __forceinline__ void phase_wconv(const Params& P, LAS unsigned char* lds, int gbeg, int gend, int bid, int nb) {
    unsigned char* ws = P.ws;
    { LAS float* tl = (LAS float*)lds;
      const int c0 = 32 * 21, c1 = c0 + 256, c2 = c1 + 256, c3 = c2 + 32, c4 = c3 + 32 * 29, c5 = c4 + 256, c6 = c5 + 256;
      for (int g = gbeg + bid; g < gend; g += nb) {
          if (g < c0) wtrans_tile(P.w_in_even, 2048, 5376, (bf16_t*)(ws + WS_WIN0), P.norm_mix, 0, g % 32, g / 32, tl);
          else if (g < c1) { const int t = g - c0; wtrans_tile(P.w_out_even, 2048, 2048, (bf16_t*)(ws + WS_WOUT0), nullptr, 0, t % 32, t / 32, tl); }
          else if (g < c2) { const int t = g - c1; wtrans_tile(P.w_ple_gate, 2048, 2048, (bf16_t*)(ws + WS_WG0), P.ple_gate_norm, 0, t % 32, t / 32, tl); }
          else if (g < c3) { const int t = g - c2; wtrans_tile(P.w_ple_proj, 256, 2048, (bf16_t*)(ws + WS_WP0), nullptr, 0, t % 4, t / 4, tl); }
          else if (g < c4) { const int t = g - c3; wtrans_tile(P.w_in_odd, 2048, 7184, (bf16_t*)(ws + WS_WIN1), P.norm_mix + DM, 1, t % 32, t / 32, tl); }
          else if (g < c5) { const int t = g - c4; wtrans_tile(P.w_out_odd, 2048, 2048, (bf16_t*)(ws + WS_WOUT1), nullptr, 0, t % 32, t / 32, tl); }
          else if (g < c6) { const int t = g - c5; wtrans_tile(P.w_ple_gate + (size_t)DM * DM, 2048, 2048, (bf16_t*)(ws + WS_WG1), P.ple_gate_norm + DM, 0, t % 32, t / 32, tl); }
          else { const int t = g - c6; wtrans_tile(P.w_ple_proj + (size_t)256 * DM, 256, 2048, (bf16_t*)(ws + WS_WP1), nullptr, 0, t % 4, t / 4, tl); }
      } }
}

__device__ __forceinline__ void attn_unit(const Params& P, LAS unsigned char* lds, int n, int g) {
    const int tid = threadIdx.x, w = tid >> 6, lane = tid & 63, l15 = lane & 15, quad = lane >> 4;
    const bf16_t* Z = (const bf16_t*)(P.ws + WS_Z);
    bf16_t* Y = (bf16_t*)(P.ws + WS_HA);
    constexpr int KS = 0, VT = 36864, PB = 70656;
#pragma unroll
    for (int r = 0; r < 4; ++r) {
        { const int idx = tid + 512 * r, key = idx >> 3, c8 = idx & 7; u32x4 v = (u32x4){0u, 0u, 0u, 0u};
          if (n > 0 || key >= 128) v = *(const u32x4*)(Z + (size_t)(128 * (n - 1) + key) * LDZ0 + 1024 + g * 64 + c8 * 8);
          *(LAS u32x4*)(lds + KS + key * 144 + c8 * 16) = v; }
        { const int idx = tid + 512 * r, key = idx & 255, c8 = idx >> 8; u32x4 v = (u32x4){0u, 0u, 0u, 0u};
          if (n > 0 || key >= 128) v = *(const u32x4*)(Z + (size_t)(128 * (n - 1) + key) * LDZ0 + 1152 + g * 64 + c8 * 8);
#pragma unroll
          for (int e = 0; e < 4; ++e) { *(LAS bf16_t*)(lds + VT + (c8 * 8 + 2 * e) * 528 + key * 2) = (bf16_t)(v[e] & 0xffffu); *(LAS bf16_t*)(lds + VT + (c8 * 8 + 2 * e + 1) * 528 + key * 2) = (bf16_t)(v[e] >> 16); } }
    }
    __syncthreads();
    const int hq = g * 8 + w;
    const float sink = P.sinks[hq];
    LAS unsigned char* pw = lds + PB + w * 5376;
    bf16x8 q0n, q1n; u32x2 gwn[4];
    { const size_t qrow = (size_t)(128 * n + l15);
      q0n = *(const bf16x8*)(Z + qrow * LDZ0 + hq * 64 + quad * 8); q1n = *(const bf16x8*)(Z + qrow * LDZ0 + hq * 64 + 32 + quad * 8);
#pragma unroll
      for (int nt = 0; nt < 4; ++nt) gwn[nt] = *(const u32x2*)(Z + qrow * LDZ0 + 1280 + hq * 64 + 16 * nt + quad * 4); }
    for (int rg = 0; rg < 8; ++rg) {
        const int kt0 = rg < 6 ? rg : 6;
        const bf16x8 q0 = q0n, q1 = q1n;
        u32x2 gwc[4];
#pragma unroll
        for (int nt = 0; nt < 4; ++nt) gwc[nt] = gwn[nt];
        if (rg < 7) {
            const size_t qrow = (size_t)(128 * n + 16 * (rg + 1) + l15);
            q0n = *(const bf16x8*)(Z + qrow * LDZ0 + hq * 64 + quad * 8); q1n = *(const bf16x8*)(Z + qrow * LDZ0 + hq * 64 + 32 + quad * 8);
#pragma unroll
            for (int nt = 0; nt < 4; ++nt) gwn[nt] = *(const u32x2*)(Z + qrow * LDZ0 + 1280 + hq * 64 + 16 * nt + quad * 4);
        }
        f32x4 s[10];
#pragma unroll
        for (int t = 0; t < 10; ++t) {
            const int key = 16 * (kt0 + t) + l15;
            const bf16x8 k0 = *(const LAS bf16x8*)(lds + KS + key * 144 + quad * 16), k1 = *(const LAS bf16x8*)(lds + KS + key * 144 + 64 + quad * 16);
            f32x4 a = (f32x4){0.f, 0.f, 0.f, 0.f};
            a = MFMA16(q0, k0, a); a = MFMA16(q1, k1, a);
            s[t] = a;
        }
        float mx[4], sm[4];
        if (n > 0 && rg < 7) {
#pragma unroll
            for (int j = 0; j < 4; ++j) { const int qr = quad * 4 + j;
                s[0][j] = (l15 > qr) ? s[0][j] : -1e30f; s[8][j] = (l15 <= qr) ? s[8][j] : -1e30f; s[9][j] = -1e30f; }
        } else {
#pragma unroll
            for (int j = 0; j < 4; ++j) { const int qi = 16 * rg + quad * 4 + j;
#pragma unroll
                for (int t = 0; t < 10; ++t) { const int kj = 16 * (kt0 + t) + l15; const bool valid = (kj > qi) && (kj <= qi + 128) && (n > 0 || kj >= 128);
                    s[t][j] = valid ? s[t][j] : -1e30f; } }
        }
#pragma unroll
        for (int j = 0; j < 4; ++j) {
            float m = -1e30f;
#pragma unroll
            for (int t = 0; t < 10; ++t) m = fmaxf(m, s[t][j]);
            m = fmaxf(m, __shfl_xor(m, 1)); m = fmaxf(m, __shfl_xor(m, 2)); m = fmaxf(m, __shfl_xor(m, 4)); m = fmaxf(m, __shfl_xor(m, 8));
            m = fmaxf(m, sink); mx[j] = m;
            float su = 0.f;
#pragma unroll
            for (int t = 0; t < 10; ++t) { const float pv = __expf(s[t][j] - m); s[t][j] = pv; su += pv; }
            su += __shfl_xor(su, 1); su += __shfl_xor(su, 2); su += __shfl_xor(su, 4); su += __shfl_xor(su, 8);
            su += __expf(sink - m); sm[j] = 1.0f / su;
        }
#pragma unroll
        for (int t = 0; t < 10; ++t)
#pragma unroll
            for (int j = 0; j < 4; ++j) *(LAS bf16_t*)(pw + (quad * 4 + j) * 336 + (16 * t + l15) * 2) = f2bf(s[t][j]);
        f32x4 o[4];
#pragma unroll
        for (int nt = 0; nt < 4; ++nt) o[nt] = (f32x4){0.f, 0.f, 0.f, 0.f};
#pragma unroll
        for (int s5 = 0; s5 < 5; ++s5) {
            const bf16x8 pa = *(const LAS bf16x8*)(pw + l15 * 336 + (32 * s5 + quad * 8) * 2);
#pragma unroll
            for (int nt = 0; nt < 4; ++nt) {
                const bf16x8 vb = *(const LAS bf16x8*)(lds + VT + (16 * nt + l15) * 528 + (16 * kt0 + 32 * s5 + quad * 8) * 2);
                o[nt] = MFMA16(vb, pa, o[nt]);
            }
        }
        float smq;
        { const int src = (l15 >> 2) << 4; const float t0 = __shfl(sm[0], src), t1 = __shfl(sm[1], src), t2 = __shfl(sm[2], src), t3 = __shfl(sm[3], src);
          const int jj = l15 & 3; smq = jj == 0 ? t0 : (jj == 1 ? t1 : (jj == 2 ? t2 : t3)); }
        { const size_t row = (size_t)(128 * n + 16 * rg + l15);
#pragma unroll
          for (int nt = 0; nt < 4; ++nt) {
              const int d0 = 16 * nt + quad * 4;
              const u32x2 gw = gwc[nt];
              u32x2 yw;
              yw.x = cvt_pk_bf16(o[nt][0] * smq * __uint_as_float(gw.x << 16), o[nt][1] * smq * __uint_as_float(gw.x & 0xffff0000u));
              yw.y = cvt_pk_bf16(o[nt][2] * smq * __uint_as_float(gw.y << 16), o[nt][3] * smq * __uint_as_float(gw.y & 0xffff0000u));
              *(u32x2*)(Y + row * DM + hq * 64 + d0) = yw;
          } }
    }
    __syncthreads();
}
__device__ __forceinline__ void gmlp_unit(const Params& P, LAS unsigned char* lds, int n, int g) {
    const int tid = threadIdx.x, w = tid >> 6, lane = tid & 63, l15 = lane & 15, quad = lane >> 4;
    const bf16_t* Z = (const bf16_t*)(P.ws + WS_Z);
    bf16_t* Y = (bf16_t*)(P.ws + WS_HA);
    const float* ssv = (const float*)(P.ws + WS_STAT) + SEQ;
    const int trow = 16 * w + l15;
    const float* wsp = P.w_sp + ((size_t)g * 128 + trow) * 128;
    f32x4 wq[4][2];
#pragma unroll
    for (int ks = 0; ks < 4; ++ks) {
        wq[ks][0] = (f32x4){0.f, 0.f, 0.f, 0.f}; wq[ks][1] = (f32x4){0.f, 0.f, 0.f, 0.f};
        if (32 * ks <= 16 * w + 15) { wq[ks][0] = *(const f32x4*)(wsp + 32 * ks + quad * 8); wq[ks][1] = *(const f32x4*)(wsp + 32 * ks + quad * 8 + 4); }
    }
    u32x2 uwv[8], gwv[8];
#pragma unroll
    for (int nt = 0; nt < 8; ++nt) {
        const size_t row = (size_t)(128 * n + trow); const int c0 = g * 128 + 16 * nt + quad * 4;
        uwv[nt] = *(const u32x2*)(Z + row * LDZ0 + 2304 + c0); gwv[nt] = *(const u32x2*)(Z + row * LDZ0 + 4352 + c0);
    }
    const float bs = P.b_sp[g * 128 + trow];
#pragma unroll
    for (int r = 0; r < 4; ++r) {
        const int idx = tid + 512 * r, s = idx & 127, c8 = idx >> 7;
        const u32x4 v = *(const u32x4*)(Z + (size_t)(128 * n + s) * LDZ0 + 3328 + g * 128 + c8 * 8);
        const float rinv = rsqrtf(ssv[128 * n + s] * (1.f / 1024.f) + 1e-6f);
#pragma unroll
        for (int e = 0; e < 4; ++e) {
            const int c = c8 * 8 + 2 * e;
            const float lo = __uint_as_float(v[e] << 16) * rinv * P.vnorm[g * 128 + c], hi = __uint_as_float(v[e] & 0xffff0000u) * rinv * P.vnorm[g * 128 + c + 1];
            *(LAS bf16_t*)(lds + c * 272 + s * 2) = f2bf(lo); *(LAS bf16_t*)(lds + (c + 1) * 272 + s * 2) = f2bf(hi);
        }
    }
    __syncthreads();
    f32x4 acc[8];
#pragma unroll
    for (int nt = 0; nt < 8; ++nt) acc[nt] = (f32x4){0.f, 0.f, 0.f, 0.f};
#pragma unroll
    for (int ks = 0; ks < 4; ++ks) {
        if (32 * ks <= 16 * w + 15) {
            const int s0 = 32 * ks + quad * 8;
            const f32x4 w0 = wq[ks][0], w1 = wq[ks][1];
            float wv[8] = {w0[0], w0[1], w0[2], w0[3], w1[0], w1[1], w1[2], w1[3]};
#pragma unroll
            for (int e = 0; e < 8; ++e) if (s0 + e > trow) wv[e] = 0.f;
            u32x4 aw; aw.x = cvt_pk_bf16(wv[0], wv[1]); aw.y = cvt_pk_bf16(wv[2], wv[3]); aw.z = cvt_pk_bf16(wv[4], wv[5]); aw.w = cvt_pk_bf16(wv[6], wv[7]);
            const bf16x8 af = __builtin_bit_cast(bf16x8, aw);
#pragma unroll
            for (int nt = 0; nt < 8; ++nt) { const bf16x8 bfv = *(const LAS bf16x8*)(lds + (16 * nt + l15) * 272 + s0 * 2); acc[nt] = MFMA16(bfv, af, acc[nt]); }
        }
    }
    { const int t = 16 * w + l15; const size_t row = (size_t)(128 * n + t);
#pragma unroll
      for (int nt = 0; nt < 8; ++nt) {
          const int c0 = g * 128 + 16 * nt + quad * 4;
          const u32x2 uw = uwv[nt], gw = gwv[nt];
          u32x2 yw;
          yw.x = cvt_pk_bf16(__uint_as_float(uw.x << 16) * (acc[nt][0] + bs) * __uint_as_float(gw.x << 16), __uint_as_float(uw.x & 0xffff0000u) * (acc[nt][1] + bs) * __uint_as_float(gw.x & 0xffff0000u));
          yw.y = cvt_pk_bf16(__uint_as_float(uw.y << 16) * (acc[nt][2] + bs) * __uint_as_float(gw.y << 16), __uint_as_float(uw.y & 0xffff0000u) * (acc[nt][3] + bs) * __uint_as_float(gw.y & 0xffff0000u));
          *(u32x2*)(Y + row * DM + 1024 + c0) = yw;
      } }
    __syncthreads();
}
__device__ __forceinline__ void phase_mix0(const Params& P, LAS unsigned char* lds, int bid, int nb) {
    for (int u = bid; u < 256; u += nb) attn_unit(P, lds, u >> 1, u & 1);
    for (int u = bid; u < 1024; u += nb) gmlp_unit(P, lds, u >> 3, u & 7);
}

struct FrontC { float lbv, bg; float wu[16]; };
template <int MIX>
__device__ __forceinline__ void front_consts(const Params& P, int h, FrontC& C) {
    const int c = h * 128 + (threadIdx.x & 127);
    C.lbv = 0.f; C.bg = 0.f;
    if (MIX == 0) C.lbv = __builtin_amdgcn_rcpf(1.0f + __expf(P.lower_bounds[c] - P.lower_bounds[1024 + c]));
    else {
#pragma unroll
        for (int r = 0; r < 16; ++r) C.wu[r] = P.w_gate_up[r * 512 + c];
        C.bg = P.b_gate[c];
    }
}
template <int MIX>
__device__ __forceinline__ void front_load(const Params& P, int n, int h, float (&zr)[16], f32x4& gq) {
    const int tid = threadIdx.x, kk = tid & 127, i = tid >> 7;
    const bf16_t* Z = (const bf16_t*)(P.ws + WS_Z);
    const int col = (MIX ? 3584 : 1024) + h * 128 + kk;
#pragma unroll
    for (int tt = 0; tt < 16; ++tt) zr[tt] = bf2f(Z[(size_t)(64 * n + 16 * i + tt) * LDZ1 + col]);
    if (MIX) {
        const int iu = __builtin_amdgcn_readfirstlane(i);
        const float* glr = (const float*)(P.ws + WS_GLR) + (size_t)(64 * n + 16 * iu) * 16;
        gq = *(const f32x4*)(glr + 4 * (threadIdx.x & 63));
    }
}
template <int MIX>
__device__ __forceinline__ void front_compute(LAS unsigned char* lds, const FrontC& C, const float (&zr)[16], const f32x4& gq, float (&loc)[16], float (&kv)[16], float (&o)[5]) {
    const int tid = threadIdx.x, kk = tid & 127, i = tid >> 7;
    LAS float* segtot = (LAS float*)lds;
    float run = 0.f;
    if (MIX == 0) {
        const float lbv = C.lbv;
#pragma unroll
        for (int tt = 0; tt < 16; ++tt) {
            const float z = zr[tt];
            const float en = __expf(-fabsf(z)), r = __builtin_amdgcn_rcpf(1.0f + en);
            const float sg = z >= 0.f ? r : en * r, omsg = z >= 0.f ? en * r : r;
            const float f = lbv + (1.0f - lbv) * sg;
            run += __logf(f); loc[tt] = run; kv[tt] = (1.0f - lbv) * omsg;
        }
    } else {
#pragma unroll
        for (int tt = 0; tt < 16; ++tt) {
            float xg = C.bg;
#pragma unroll
            for (int r = 0; r < 16; ++r) {
                const float gv = __int_as_float(__builtin_amdgcn_readlane(__float_as_int(gq[r & 3]), 4 * tt + (r >> 2)));
                xg += gv * C.wu[r];
            }
            const float ls = fminf(xg, 0.f) - __logf(1.0f + __expf(-fabsf(xg)));
            run += ls * (1.0f / 16.0f); loc[tt] = run; kv[tt] = zr[tt];
        }
    }
    segtot[i * 128 + kk] = run;
    __syncthreads();
    o[0] = 0.f;
#pragma unroll
    for (int q = 0; q < 4; ++q) o[q + 1] = o[q] + segtot[q * 128 + kk];
}
template <int MIX>
__device__ __forceinline__ void chunk_front(const Params& P, LAS unsigned char* lds, int n, int h, float (&loc)[16], float (&kv)[16], float (&o)[5]) {
    FrontC C; float zr[16]; f32x4 gq = (f32x4){0.f, 0.f, 0.f, 0.f};
    front_consts<MIX>(P, h, C);
    front_load<MIX>(P, n, h, zr, gq);
    front_compute<MIX>(lds, C, zr, gq, loc, kv, o);
}
template <int DV>
__device__ __forceinline__ void load_v(const bf16_t* vsrc, u32x4 (&vr)[DV / 64]) {
    const int tid = threadIdx.x;
#pragma unroll
    for (int r = 0; r < DV / 128; ++r) { const int idx = tid + 512 * r, s2 = idx & 31, c8 = idx >> 5;
        vr[2 * r] = *(const u32x4*)(vsrc + (size_t)(2 * s2) * LDZ1 + c8 * 8); vr[2 * r + 1] = *(const u32x4*)(vsrc + (size_t)(2 * s2 + 1) * LDZ1 + c8 * 8); }
}
template <int DV>
__device__ __forceinline__ void store_vt(const u32x4 (&vr)[DV / 64], LAS unsigned char* vt) {
    const int tid = threadIdx.x;
#pragma unroll
    for (int r = 0; r < DV / 128; ++r) {
        const int idx = tid + 512 * r, s2 = idx & 31, c8 = idx >> 5;
        const u32x4 a = vr[2 * r], b = vr[2 * r + 1];
#pragma unroll
        for (int e = 0; e < 4; ++e) {
            *(LAS unsigned*)(vt + (c8 * 8 + 2 * e) * 144 + s2 * 4) = (a[e] & 0xffffu) | (b[e] << 16);
            *(LAS unsigned*)(vt + (c8 * 8 + 2 * e + 1) * 144 + s2 * 4) = (a[e] >> 16) | (b[e] & 0xffff0000u);
        }
    }
}
template <int MIX>
__device__ __forceinline__ void scanA_unit(const Params& P, LAS unsigned char* lds, int n, int h, const FrontC& C, const float (&zr)[16], const f32x4& gq, const u32x4 (&vr)[(MIX ? 256 : 128) / 64]) {
    constexpr int DV = MIX ? 256 : 128, NH = MIX ? 4 : 8;
    const int tid = threadIdx.x, kk = tid & 127, i = tid >> 7, w = tid >> 6, lane = tid & 63, l15 = lane & 15, quad = lane >> 4;
    const bf16_t* Z = (const bf16_t*)(P.ws + WS_Z);
    bf16_t* ST = (bf16_t*)((unsigned char*)P.out + (MIX ? (size_t)SEQ * DM * 2 : 0)) + ((size_t)n * NH + h) * DV * 128;
    float* dbuf = (float*)(P.ws + WS_DBUF);
    constexpr int KD = 2048, VT = 2048 + 18432;
    float loc[16], kv[16], o[5];
    front_compute<MIX>(lds, C, zr, gq, loc, kv, o);
    { float e[16];
#pragma unroll
      for (int tt = 0; tt < 16; ++tt) e[tt] = kv[tt] * __expf(o[4] - o[i] - loc[tt]);
      u32x4 w0, w1; w0.x = cvt_pk_bf16(e[0], e[1]); w0.y = cvt_pk_bf16(e[2], e[3]); w0.z = cvt_pk_bf16(e[4], e[5]); w0.w = cvt_pk_bf16(e[6], e[7]);
      w1.x = cvt_pk_bf16(e[8], e[9]); w1.y = cvt_pk_bf16(e[10], e[11]); w1.z = cvt_pk_bf16(e[12], e[13]); w1.w = cvt_pk_bf16(e[14], e[15]);
      *(LAS u32x4*)(lds + KD + kk * 144 + i * 32) = w0; *(LAS u32x4*)(lds + KD + kk * 144 + i * 32 + 16) = w1; }
    if (i == 0) dbuf[(size_t)n * 1536 + (MIX ? 1024 : 0) + h * 128 + kk] = __expf(o[4]);
    store_vt<DV>(vr, lds + VT);
    __syncthreads();
    f32x4 acc[DV / 16];
#pragma unroll
    for (int nt = 0; nt < DV / 16; ++nt) acc[nt] = (f32x4){0.f, 0.f, 0.f, 0.f};
#pragma unroll
    for (int ks = 0; ks < 2; ++ks) {
        const bf16x8 af = *(const LAS bf16x8*)(lds + KD + (16 * w + l15) * 144 + (32 * ks + quad * 8) * 2);
#pragma unroll
        for (int nt = 0; nt < DV / 16; ++nt) { const bf16x8 bfv = *(const LAS bf16x8*)(lds + VT + (16 * nt + l15) * 144 + (32 * ks + quad * 8) * 2); acc[nt] = MFMA16(af, bfv, acc[nt]); }
    }
#pragma unroll
    for (int nt = 0; nt < DV / 16; ++nt) { u32x2 wv; wv.x = cvt_pk_bf16(acc[nt][0], acc[nt][1]); wv.y = cvt_pk_bf16(acc[nt][2], acc[nt][3]);
        *(u32x2*)(ST + (size_t)(16 * nt + l15) * 128 + 16 * w + quad * 4) = wv; }
    __syncthreads();
}
__device__ __forceinline__ void phase_scanB(const Params& P, LAS unsigned char* lds, int bid, int nb) {
    const float* dbuf = (const float*)(P.ws + WS_DBUF);
    LAS float* ld = (LAS float*)lds;
    const int tid = threadIdx.x;
    for (int e0 = bid * 512; e0 < 131072; e0 += nb * 512) {
        const int e = e0 + tid;
        const int mix = e >> 16, r = e & 65535;
        const int h = mix ? (r >> 14) : (r >> 13);
        const float* dsrc = dbuf + (mix ? 1024 : 0) + h * 128;
#pragma unroll 16
        for (int j = 0; j < 64; ++j) { const int idx = tid + 512 * j; ld[idx] = dsrc[(size_t)(idx >> 7) * 1536 + (idx & 127)]; }
        __syncthreads();
        unsigned* base = (unsigned*)((unsigned char*)P.out + (mix ? (size_t)SEQ * DM * 2 : 0)) + r;
        const int kp = (r & 63) * 2;
        float s0 = 0.f, s1 = 0.f;
#pragma unroll 32
        for (int n = 0; n < 256; ++n) {
            const unsigned uw = __builtin_nontemporal_load(base + (size_t)n * 65536);
            const f32x2 d = *(const LAS f32x2*)(ld + n * 128 + kp);
            base[(size_t)n * 65536] = cvt_pk_bf16(s0, s1);
            s0 = d.x * s0 + __uint_as_float(uw << 16); s1 = d.y * s1 + __uint_as_float(uw & 0xffff0000u);
        }
        __syncthreads();
    }
}
template <int MIX>
__device__ __forceinline__ void scanC_unit(const Params& P, LAS unsigned char* lds, int n, int h, bool dummy) {
    constexpr int DV = MIX ? 256 : 128, NH = MIX ? 4 : 8, NTW = DV / 32;
    const int tid = threadIdx.x, kk = tid & 127, i = tid >> 7, w = __builtin_amdgcn_readfirstlane(tid >> 6), lane = tid & 63, l15 = lane & 15, quad = lane >> 4;
    bf16_t* Z = (bf16_t*)(P.ws + WS_Z);
    const bf16_t* ST = (const bf16_t*)((unsigned char*)P.out + (MIX ? (size_t)SEQ * DM * 2 : 0)) + ((size_t)n * NH + h) * DV * 128;
    constexpr int RS = 2048, QH = 2560, QT = 19968, KH0 = 37376, AB = 80896, VT = 90112;
    const int qcol = MIX ? 3072 + h * 128 : h * 128, vcol = MIX ? 6144 + h * 256 : 5120 + h * 128, gcol = MIX ? 4096 + h * 256 : 2048 + h * 128;
    const float* onorm = MIX ? P.onorm_d + h * 256 : P.onorm_c + h * 128;
    float loc[16], kv[16], o[5], qv[16];
    u32x4 vr[DV / 64];
#pragma unroll
    for (int tt = 0; tt < 16; ++tt) qv[tt] = bf2f(Z[(size_t)(64 * n + 16 * i + tt) * LDZ1 + qcol + kk]);
    load_v<DV>(Z + (size_t)(64 * n) * LDZ1 + vcol, vr);
    chunk_front<MIX>(P, lds, n, h, loc, kv, o);
    const int ip = w & 3, hv = w >> 2;
    bf16x8 sf[4][NTW]; u32x2 gwv[NTW];
    if (MIX == 0) {
#pragma unroll
        for (int ks = 0; ks < 4; ++ks)
#pragma unroll
            for (int nt = 0; nt < NTW; ++nt) sf[ks][nt] = *(const bf16x8*)(ST + (size_t)(16 * (hv * NTW + nt) + l15) * 128 + 32 * ks + quad * 8);
    }
#pragma unroll
    for (int nt = 0; nt < NTW; ++nt) gwv[nt] = *(const u32x2*)(Z + (size_t)(64 * n + 16 * ip + l15) * LDZ1 + gcol + 16 * (hv * NTW + nt) + quad * 4);
    const float scale = 0.08838834764831845f;
#ifndef CVAR
#define CVAR 0
#endif
    if (!(CVAR == 1 && dummy)) {
    { const float eo = __expf(o[i]);
#pragma unroll
      for (int tt = 0; tt < 16; ++tt) {
          const float q = qv[tt] * scale * __expf(loc[tt]);
          *(LAS bf16_t*)(lds + QH + (16 * i + tt) * 272 + kk * 2) = f2bf(q);
          *(LAS bf16_t*)(lds + QT + (16 * i + tt) * 272 + kk * 2) = f2bf(q * eo);
          kv[tt] *= __expf(-loc[tt]);
      } }
#pragma unroll
    for (int ip = 0; ip < 4; ++ip) {
        if (ip >= i) {
            const float fo = __expf(o[ip] - o[i]);
#pragma unroll
            for (int tt = 0; tt < 16; ++tt) *(LAS bf16_t*)(lds + KH0 + 4352 * (ip * (ip + 1) / 2) + (16 * i + tt) * 272 + kk * 2) = f2bf(kv[tt] * fo);
        }
    }
    }
    if (!(CVAR == 3 && dummy)) store_vt<DV>(vr, lds + VT);
    __syncthreads();
    if (MIX == 1) {
#pragma unroll
        for (int ks = 0; ks < 4; ++ks)
#pragma unroll
            for (int nt = 0; nt < NTW; ++nt) sf[ks][nt] = *(const bf16x8*)(ST + (size_t)(16 * (hv * NTW + nt) + l15) * 128 + 32 * ks + quad * 8);
    }
#pragma unroll
    for (int rep = 0; rep < 2; ++rep) {
        const int jb = w + 8 * rep;
        if (jb < 12) {
            int ipj, jt;
            if (jb >= 10) { ipj = (jb == 10) ? 0 : 2; jt = (jb == 10) ? 1 : 3; }
            else { ipj = jb >= 6 ? 3 : (jb >= 3 ? 2 : (jb >= 1 ? 1 : 0)); jt = jb - ipj * (ipj + 1) / 2; }
            f32x4 a = (f32x4){0.f, 0.f, 0.f, 0.f};
            if (jb < 10) {
                const int kho = KH0 + 4352 * (ipj * (ipj + 1) / 2);
#pragma unroll
                for (int ks = 0; ks < 4; ++ks) {
                    const bf16x8 qa = *(const LAS bf16x8*)(lds + QH + (16 * ipj + l15) * 272 + (32 * ks + quad * 8) * 2);
                    const bf16x8 kb = *(const LAS bf16x8*)(lds + kho + (16 * jt + l15) * 272 + (32 * ks + quad * 8) * 2);
                    a = MFMA16(qa, kb, a);
                }
                if (jt == ipj) {
#pragma unroll
                    for (int j = 0; j < 4; ++j) if (l15 > quad * 4 + j) a[j] = 0.f;
                }
            }
#pragma unroll
            for (int j = 0; j < 4; ++j) *(LAS bf16_t*)(lds + AB + (16 * ipj + quad * 4 + j) * 144 + (16 * jt + l15) * 2) = f2bf(a[j]);
        }
    }
    __syncthreads();
    f32x4 acc[NTW];
#pragma unroll
    for (int nt = 0; nt < NTW; ++nt) acc[nt] = (f32x4){0.f, 0.f, 0.f, 0.f};
#pragma unroll
    for (int ks = 0; ks < 4; ++ks) {
        const bf16x8 qa = *(const LAS bf16x8*)(lds + QT + (16 * ip + l15) * 272 + (32 * ks + quad * 8) * 2);
#pragma unroll
        for (int nt = 0; nt < NTW; ++nt) acc[nt] = MFMA16(sf[ks][nt], qa, acc[nt]);
    }
#pragma unroll
    for (int ks = 0; ks < 2; ++ks) {
        if (ks == 0 || ip >= 2) {
            const bf16x8 aa = *(const LAS bf16x8*)(lds + AB + (16 * ip + l15) * 144 + (32 * ks + quad * 8) * 2);
#pragma unroll
            for (int nt = 0; nt < NTW; ++nt) { const bf16x8 vb = *(const LAS bf16x8*)(lds + VT + (16 * (hv * NTW + nt) + l15) * 144 + (32 * ks + quad * 8) * 2); acc[nt] = MFMA16(vb, aa, acc[nt]); }
        }
    }
    LAS float* rowss = (LAS float*)(lds + RS);
    { float ss = 0.f;
#pragma unroll
      for (int nt = 0; nt < NTW; ++nt) ss += acc[nt][0] * acc[nt][0] + acc[nt][1] * acc[nt][1] + acc[nt][2] * acc[nt][2] + acc[nt][3] * acc[nt][3];
      ss += __shfl_xor(ss, 16); ss += __shfl_xor(ss, 32);
      if (quad == 0) rowss[hv * 64 + 16 * ip + l15] = ss; }
    __syncthreads();
    { const float tot = rowss[16 * ip + l15] + rowss[64 + 16 * ip + l15];
      const float rinv = rsqrtf(tot * (1.0f / DV) + 1e-6f);
      const size_t row = (size_t)(64 * n + 16 * ip + l15);
#pragma unroll
      for (int nt = 0; nt < NTW; ++nt) {
          const int vv0 = 16 * (hv * NTW + nt) + quad * 4;
          const u32x2 gw = gwv[nt];
          const f32x4 on = *(const f32x4*)(onorm + vv0);
          const float o0 = acc[nt][0] * rinv * on[0] * __uint_as_float(gw.x << 16), o1 = acc[nt][1] * rinv * on[1] * __uint_as_float(gw.x & 0xffff0000u);
          const float o2 = acc[nt][2] * rinv * on[2] * __uint_as_float(gw.y << 16), o3 = acc[nt][3] * rinv * on[3] * __uint_as_float(gw.y & 0xffff0000u);
          u32x2 yw; yw.x = cvt_pk_bf16(o0, o1); yw.y = cvt_pk_bf16(o2, o3);
          if (!dummy || o0 == 12345.678f) *(u32x2*)(Z + row * LDZ1 + vcol + vv0) = yw;
      } }
    __syncthreads();
}
template <int MIX>
__device__ __forceinline__ void scanA_loop(const Params& P, LAS unsigned char* lds, int bid, int nb) {
    constexpr int DV = MIX ? 256 : 128, NH = MIX ? 4 : 8, NU = 256 * NH;
    if (bid >= NU) return;
    const bf16_t* Z = (const bf16_t*)(P.ws + WS_Z);
    int hc = bid % NH;
    FrontC C; front_consts<MIX>(P, hc, C);
    float zn[16]; f32x4 gn = (f32x4){0.f, 0.f, 0.f, 0.f}; u32x4 vn[DV / 64];
    { const int n = bid / NH, h = bid % NH; front_load<MIX>(P, n, h, zn, gn); load_v<DV>(Z + (size_t)(64 * n) * LDZ1 + (MIX ? 6144 + h * 256 : 5120 + h * 128), vn); }
    for (int u = bid; u < NU; u += nb) {
        const int n = u / NH, h = u % NH;
        float zr[16]; u32x4 vr[DV / 64]; const f32x4 gq = gn;
#pragma unroll
        for (int t = 0; t < 16; ++t) zr[t] = zn[t];
#pragma unroll
        for (int t = 0; t < DV / 64; ++t) vr[t] = vn[t];
        const int un = u + nb;
        if (un < NU) { const int n2 = un / NH, h2 = un % NH; front_load<MIX>(P, n2, h2, zn, gn); load_v<DV>(Z + (size_t)(64 * n2) * LDZ1 + (MIX ? 6144 + h2 * 256 : 5120 + h2 * 128), vn); }
        if (h != hc) { hc = h; front_consts<MIX>(P, h, C); }
        scanA_unit<MIX>(P, lds, n, h, C, zr, gq, vr);
    }
}
__device__ __forceinline__ void phase_scanA(const Params& P, LAS unsigned char* lds, int bid, int nb) {
    scanA_loop<0>(P, lds, bid, nb);
    scanA_loop<1>(P, lds, bid, nb);
}
__device__ __forceinline__ void phase_scanC(const Params& P, LAS unsigned char* lds, int bid, int nb, bool dummy) {
    for (int u = bid; u < 3072; u += nb) { const int n = u / 12, hh = u % 12; if (hh < 8) scanC_unit<0>(P, lds, n, hh, dummy); else scanC_unit<1>(P, lds, n, hh - 8, dummy); }
}
__device__ __forceinline__ void phase_final(const Params& P, int bid, int nb) {
    const int tid = threadIdx.x, wid = tid >> 6, lane = tid & 63;
    const float* ss4 = (const float*)(P.ws + WS_STAT) + 7 * SEQ;
    const bf16_t* hb = (const bf16_t*)(P.ws + WS_HA);
    f32x4 g0[4], g1[4];
#pragma unroll
    for (int i = 0; i < 4; ++i) { const int c = lane * 8 + 512 * i; g0[i] = *(const f32x4*)(P.final_norm + c); g1[i] = *(const f32x4*)(P.final_norm + c + 4); }
    for (int row = bid * 32 + wid * 4; row < SEQ; row += nb * 32) {
        u32x4 hw[4][4]; float rinv[4];
#pragma unroll
        for (int q = 0; q < 4; ++q) {
            rinv[q] = ss4[row + q];
#pragma unroll
            for (int i = 0; i < 4; ++i) hw[q][i] = __builtin_nontemporal_load((const u32x4*)(hb + (size_t)(row + q) * DM + lane * 8 + 512 * i));
        }
#pragma unroll
        for (int q = 0; q < 4; ++q) {
            const float ri = rsqrtf(rinv[q] * (1.f / 2048.f) + 1e-6f);
            float* orow = P.out + (size_t)(row + q) * DM;
#pragma unroll
            for (int i = 0; i < 4; ++i) {
                const int c = lane * 8 + 512 * i; const u32x4 w = hw[q][i];
                f32x4 o0, o1;
                o0[0] = __uint_as_float(w[0] << 16) * ri * g0[i][0]; o0[1] = __uint_as_float(w[0] & 0xffff0000u) * ri * g0[i][1];
                o0[2] = __uint_as_float(w[1] << 16) * ri * g0[i][2]; o0[3] = __uint_as_float(w[1] & 0xffff0000u) * ri * g0[i][3];
                o1[0] = __uint_as_float(w[2] << 16) * ri * g1[i][0]; o1[1] = __uint_as_float(w[2] & 0xffff0000u) * ri * g1[i][1];
                o1[2] = __uint_as_float(w[3] << 16) * ri * g1[i][2]; o1[3] = __uint_as_float(w[3] & 0xffff0000u) * ri * g1[i][3];
                *(f32x4*)(orow + c) = o0; *(f32x4*)(orow + c + 4) = o1;
            }
        }
    }
}

__device__ __forceinline__ void phase_glr(const Params& P, LAS unsigned char* lds, int bid, int nb) {
    const int tid = threadIdx.x, w = __builtin_amdgcn_readfirstlane(tid >> 6), lane = tid & 63, l15 = lane & 15, quad = lane >> 4;
    const bf16_t* A = (const bf16_t*)(P.ws + WS_HA);
    const bf16_t* Wt = (const bf16_t*)(P.ws + WS_WIN1) + (size_t)7168 * DM;
    const float* ss2 = (const float*)(P.ws + WS_STAT) + 4 * SEQ;
    float* glr = (float*)(P.ws + WS_GLR);
    LAS f32x4* part = (LAS f32x4*)lds;
    for (int g = bid; g < SEQ / 64; g += nb) {
        const int blk = w & 3, kh = w >> 2, r0 = 64 * g + 16 * blk;
        const bf16_t* ap = A + (size_t)(r0 + l15) * DM + kh * 1024 + quad * 8;
        const bf16_t* bp = Wt + (size_t)l15 * DM + kh * 1024 + quad * 8;
        f32x4 acc = (f32x4){0.f, 0.f, 0.f, 0.f};
#pragma unroll 8
        for (int ks = 0; ks < 32; ++ks) { const bf16x8 av = *(const bf16x8*)(ap + 32 * ks), bv = *(const bf16x8*)(bp + 32 * ks); acc = MFMA16(bv, av, acc); }
        if (kh == 1) part[blk * 64 + lane] = acc;
        __syncthreads();
        if (kh == 0) {
            const f32x4 o = acc + part[blk * 64 + lane];
            const float rs = rsqrtf(ss2[r0 + l15] * (1.f / 2048.f) + 1e-6f);
            *(f32x4*)(glr + (size_t)(r0 + l15) * 16 + quad * 4) = o * rs;
        }
        __syncthreads();
    }
}

template <int MODE>
__device__ __forceinline__ void run_gemm(LAS unsigned char* lds, const bf16_t* A, int lda, const bf16_t* Bt, int N, int K, const Epi<MODE>& E, int G, int c) {
    pg8::Gemm g; g.A = A; g.Bt = Bt; g.lda = lda; g.M = SEQ; g.N = N; g.K = K;
    pg8::StaticOrder S; S.init(SEQ, N, G, c);
    pg8::gemm_phase<Epi<MODE>>(lds, g, S, E);
}

#define XB_TMO      128
#define XB_XCNT(j)  (256  + 64 * (j))
#define XB_XSUB(j)  (1280 + 64 * (j))
#define XB_XGEN(j)  (2304 + 64 * (j))
#define XB_TOP      3328
#define XB_TOPGEN   3392
#define XCD_BAR_WORDS 3456
#define XB_SPIN_CAP (1u << 18)

__device__ __forceinline__ unsigned xb_ld(unsigned* p)              { return __hip_atomic_load(p, __ATOMIC_RELAXED, __HIP_MEMORY_SCOPE_AGENT); }
__device__ __forceinline__ unsigned xb_add(unsigned* p, unsigned v) { return __hip_atomic_fetch_add(p, v, __ATOMIC_RELAXED, __HIP_MEMORY_SCOPE_AGENT); }
__device__ __forceinline__ unsigned xb_xcc_id() { return (unsigned)__builtin_amdgcn_s_getreg((3 << 11) | 20) & 0xFu; }
#define XB_SPIN(cond, bar) do { unsigned _sp = 0; while (cond) { __builtin_amdgcn_s_sleep(1); \
    if ((++_sp & 255u) == 0u) { if (xb_ld(&(bar)[XB_TMO])) break; if (_sp > XB_SPIN_CAP) { atomicAdd(&(bar)[XB_TMO], 1u); break; } } } } while (0)

struct XcdBarrier {
    unsigned* bar; unsigned x;
    volatile LAS unsigned* st;
};

__device__ __forceinline__ XcdBarrier xcd_barrier_post(unsigned* bar, volatile LAS unsigned* st) {
    XcdBarrier b; b.bar = bar; b.x = xb_xcc_id(); b.st = st;
    if (threadIdx.x == 0) (void)xb_add(&bar[XB_XCNT(b.x)], 1u);
    return b;
}
__device__ __forceinline__ void xcd_barrier_complete(unsigned* bar, unsigned x, unsigned& nloc, unsigned& nx) {
    const unsigned G = gridDim.x * gridDim.y * gridDim.z;
    unsigned sum, cnt, mine, sp = 0u;
    for (;;) {
        sum = 0u; cnt = 0u; mine = 0u;
#pragma unroll
        for (unsigned j = 0; j < 16; ++j) { const unsigned c = xb_ld(&bar[XB_XCNT(j)]); sum += c; cnt += (c > 0u) ? 1u : 0u; mine = (j == x) ? c : mine; }
        if (sum == G) break;
        __builtin_amdgcn_s_sleep(1);
        if ((++sp & 255u) == 0u) { if (xb_ld(&bar[XB_TMO])) break; if (sp > XB_SPIN_CAP) { atomicAdd(&bar[XB_TMO], 1u); break; } }
    }
    nloc = mine > 0u ? mine : 1u; nx = cnt > 0u ? cnt : 1u;
}

__device__ __forceinline__ void xcd_barrier(const XcdBarrier& b) {
    asm volatile("s_waitcnt vmcnt(0)" ::: "memory");
    __syncthreads();
    if (threadIdx.x == 0) {
        unsigned* bar = b.bar;
        __builtin_amdgcn_s_waitcnt(0);
        unsigned nloc = b.st[0], nx = b.st[1];
        if (nloc == 0u) { xcd_barrier_complete(bar, b.x, nloc, nx); b.st[0] = nloc; b.st[1] = nx; }
        const unsigned old = xb_add(&bar[XB_XSUB(b.x)], 1u);
        const unsigned gen = old / nloc;
        if (old + 1u == (gen + 1u) * nloc) {
            __builtin_amdgcn_fence(__ATOMIC_RELEASE, "agent");
            asm volatile("s_waitcnt vmcnt(0)" ::: "memory");
            const unsigned og = xb_add(&bar[XB_TOP], 1u);
            const unsigned tg = og / nx;
            if (og + 1u == (tg + 1u) * nx) xb_add(&bar[XB_TOPGEN], 1u);
            else XB_SPIN(xb_ld(&bar[XB_TOPGEN]) == tg, bar);
            __builtin_amdgcn_fence(__ATOMIC_ACQUIRE, "agent");
            xb_add(&bar[XB_XGEN(b.x)], 1u);
            asm volatile("s_waitcnt vmcnt(0)" ::: "memory");
        } else {
            XB_SPIN(xb_ld(&bar[XB_XGEN(b.x)]) == gen, bar);
            __builtin_amdgcn_fence(__ATOMIC_ACQUIRE, "agent");
            asm volatile("s_waitcnt vmcnt(0)" ::: "memory");
        }
    }
    __syncthreads();
}


__device__ __forceinline__ void grid_bar(unsigned* ctr, unsigned target) {
    asm volatile("s_waitcnt vmcnt(0)" ::: "memory");
    __syncthreads();
    if (threadIdx.x == 0) {
        __builtin_amdgcn_fence(__ATOMIC_RELEASE, "agent");
        asm volatile("s_waitcnt vmcnt(0)" ::: "memory");
        __hip_atomic_fetch_add(ctr, 1u, __ATOMIC_RELAXED, __HIP_MEMORY_SCOPE_AGENT);
        while (__hip_atomic_load(ctr, __ATOMIC_RELAXED, __HIP_MEMORY_SCOPE_AGENT) < target) __builtin_amdgcn_s_sleep(2);
        __builtin_amdgcn_fence(__ATOMIC_ACQUIRE, "agent");
        asm volatile("s_waitcnt vmcnt(0)" ::: "memory");
    }
    __syncthreads();
}
__device__ __forceinline__ bool phase_begin(const Params& P, int k, const XcdBarrier& xb) {
    if (k < P.ph_lo || k >= P.ph_hi) return false;
    if (k > P.ph_lo) {
        if (P.ph_hi < 0) cg::this_grid().sync();
        xcd_barrier(xb);
    }
    return true;
}
template <int K>
__device__ __forceinline__ void run_phase(const Params& P, LAS unsigned char* lds, int bid, int nb, bool dummy) {
    unsigned char* ws = P.ws;
    float* stat = (float*)(ws + WS_STAT);
    float *ss0 = stat, *ssv = stat + SEQ, *ssE0 = stat + 2 * SEQ, *ss1 = stat + 3 * SEQ, *ss2 = stat + 4 * SEQ, *ss3 = stat + 5 * SEQ, *ssE1 = stat + 6 * SEQ, *ss4 = stat + 7 * SEQ, *ssD = stat + 8 * SEQ;
    bf16_t *HA = (bf16_t*)(ws + WS_HA), *HB = (bf16_t*)(ws + WS_HB), *Z = (bf16_t*)(ws + WS_Z), *E0 = (bf16_t*)(ws + WS_E0), *PBF = (bf16_t*)(ws + WS_PB);
    if (K == 0) phase_prep(P, lds, bid, nb);
    if (K == 1) {
        { Epi<1> E{}; E.o16 = Z; E.ld16 = LDZ0; E.ss_in = ss0; E.ss_out = dummy ? ssD : ssv; run_gemm<1>(lds, HA, DM, (const bf16_t*)(ws + WS_WIN0), 5376, 2048, E, nb, bid); }
        { const int skip = (nb == 256) ? 64 : 0;
          if (bid >= skip && !(DUP_PH == 101 && dummy)) { Epi<2> E{}; E.o16 = E0; E.ld16 = DM; E.ss_out = dummy ? ssD : ssE0; run_gemm<2>(lds, PBF, 256, (const bf16_t*)(ws + WS_WP0), 2048, 256, E, nb - skip, bid - skip);
            if (!dummy) phase_wconv(P, lds, 32 * 21 + 256 + 256 + 32, 32 * 21 + 256 + 256 + 32 + 32 * 29 + 256 + 256 + 32, bid - skip, nb - skip); } }
    }
    if (K == 2) phase_mix0(P, lds, bid, nb);
    if (K == 3) { Epi<3> E{}; E.o16 = HB; E.ld16 = DM; E.resid = P.x; E.ss_out = dummy ? ssD : ss1; run_gemm<3>(lds, HA, DM, (const bf16_t*)(ws + WS_WOUT0), 2048, 2048, E, nb, bid); }
    if (K == 4) { Epi<4> E{}; E.o16 = HA; E.ld16 = DM; E.resid16 = HB; E.ss_in = ss1; E.ss_out = ss2; E.E = E0; E.ssE = ssE0; E.pnorm = P.ple_norm; E.dummy = dummy; if (dummy) E.ss_out = ssD;
        run_gemm<4>(lds, HB, DM, (const bf16_t*)(ws + WS_WG0), 2048, 2048, E, nb, bid); }
    if (K == 5) { Epi<5> E{}; E.o16 = Z; E.ld16 = LDZ1; E.ss_in = ss2; E.glr = (float*)(ws + WS_GLR); E.dummy = (DUP_PH == 105) ? dummy : 0; run_gemm<5>(lds, HA, DM, (const bf16_t*)(ws + WS_WIN1), 7168, 2048, E, nb, bid); if (!(DUP_PH == 105 && dummy)) phase_glr(P, lds, bid, nb); }
    if (K == 6) phase_scanA(P, lds, bid, nb);
    if (K == 7) phase_scanB(P, lds, bid, nb);
    if (K == 8) phase_scanC(P, lds, bid, nb, dummy);
    if (K == 9) {
        { Epi<3> E{}; E.o16 = HB; E.ld16 = DM; E.resid16 = HA; E.ss_out = ss3; run_gemm<3>(lds, Z + 5120, LDZ1, (const bf16_t*)(ws + WS_WOUT1), 2048, 2048, E, nb, bid); }
        { Epi<2> E{}; E.o16 = (bf16_t*)P.out; E.ld16 = DM; E.ss_out = ssE1; run_gemm<2>(lds, PBF + (size_t)SEQ * 256, 256, (const bf16_t*)(ws + WS_WP1), 2048, 256, E, nb, bid); }
    }
    if (K == 10) { Epi<4> E{}; E.o16 = HA; E.ld16 = DM; E.resid16 = HB; E.ss_in = ss3; E.ss_out = ss4; E.E = (const bf16_t*)P.out; E.ssE = ssE1; E.pnorm = P.ple_norm + DM; E.dummy = dummy; if (dummy) E.ss_out = ssD;
        run_gemm<4>(lds, HB, DM, (const bf16_t*)(ws + WS_WG1), 2048, 2048, E, nb, bid); }
    if (K == 11) phase_final(P, bid, nb);
}
#define PHASE(k) do { if ((ONLY_PH < 0 || ONLY_PH == (k)) && phase_begin(P, (k), xb)) { \
        if (DUP_PH == (k) || (DUP_PH == 101 && (k) == 1) || (DUP_PH == 105 && (k) == 5)) { run_phase<(k)>(P, lds, bid, nb, true); cg::this_grid().sync(); } \
        run_phase<(k)>(P, lds, bid, nb, false); \
        if (DUP_PH == 67 && (k) == 7) { cg::this_grid().sync(); run_phase<6>(P, lds, bid, nb, false); cg::this_grid().sync(); run_phase<7>(P, lds, bid, nb, false); } \
        if (DUP_PH == 5678 && (k) == 8) { cg::this_grid().sync(); run_phase<5>(P, lds, bid, nb, false); cg::this_grid().sync(); run_phase<6>(P, lds, bid, nb, false); cg::this_grid().sync(); run_phase<7>(P, lds, bid, nb, false); cg::this_grid().sync(); run_phase<8>(P, lds, bid, nb, false); } \
        } } while (0)
__global__ void __launch_bounds__(512, 2) mega(Params P) {
    extern __shared__ __attribute__((aligned(16))) unsigned char shm[];
    LAS unsigned char* lds = (LAS unsigned char*)shm;
    const int bid = blockIdx.x, nb = gridDim.x;
    volatile LAS unsigned* xst = (volatile LAS unsigned*)(lds + 131072);
    if (threadIdx.x == 0) { xst[0] = 0u; xst[1] = 0u; }
    __syncthreads();
    XcdBarrier xb = xcd_barrier_post((unsigned*)(P.ws + WS_BAR), xst);
    PHASE(0); PHASE(1);
#if DUP_PH == 100
    for (int q = 0; q < 20; ++q) grid_bar((unsigned*)(P.ws + WS_BAR) + 32, (unsigned)(q + 1) * gridDim.x);
#endif
 PHASE(2); PHASE(3); PHASE(4); PHASE(5); PHASE(6); PHASE(7); PHASE(8); PHASE(9); PHASE(10); PHASE(11);
}

extern "C" void kernel_launch(void* const* d_in, const int* in_sizes, int n_in, void* d_out, int out_size, void* d_ws, size_t ws_size, hipStream_t stream) {
    static int grid = 0;
    if (grid == 0) {
        if (n_in != 21 || out_size != SEQ * DM || ws_size < WS_END) { fprintf(stderr, "kernel_launch: unexpected shapes (n_in %d out %d ws %zu need %zu)\n", n_in, out_size, ws_size, (size_t)WS_END); grid = -1; return; }
        int dev = 0, cus = 0, per_cu = 0;
        hipGetDevice(&dev);
        hipDeviceGetAttribute(&cus, hipDeviceAttributeMultiprocessorCount, dev);
        if (hipFuncSetAttribute((const void*)mega, hipFuncAttributeMaxDynamicSharedMemorySize, LDS_BYTES) != hipSuccess) { fprintf(stderr, "kernel_launch: hipFuncSetAttribute failed\n"); grid = -1; return; }
        if (hipOccupancyMaxActiveBlocksPerMultiprocessor(&per_cu, (const void*)mega, 512, LDS_BYTES) != hipSuccess || per_cu < 1) { fprintf(stderr, "kernel_launch: occupancy query says %d\n", per_cu); per_cu = 1; }
        (void)hipGetLastError();
        grid = cus * 1;
    }
    if (grid < 0) return;
    Params P{};
    const float** pp = (const float**)&P;
    for (int i = 0; i < 21; ++i) pp[i] = (const float*)d_in[i];
    P.out = (float*)d_out; P.ws = (unsigned char*)d_ws;
#if ONE_LAUNCH
    P.ph_lo = 0; P.ph_hi = NPH;
    if (hipMemsetAsync((unsigned char*)d_ws + WS_BAR, 0, 16384, stream) != hipSuccess) { fprintf(stderr, "kernel_launch: memset of barrier words failed\n"); return; }
    void* args[] = {&P};
    hipError_t e = hipLaunchCooperativeKernel((const void*)mega, dim3(grid), dim3(512), args, LDS_BYTES, stream);
    if (e != hipSuccess) fprintf(stderr, "cooperative launch failed: %s (grid %d)\n", hipGetErrorString(e), grid);
#else
    for (int ph = 0; ph < NPH; ++ph) { P.ph_lo = ph; P.ph_hi = ph + 1; hipLaunchKernelGGL(mega, dim3(grid), dim3(512), LDS_BYTES, stream, P); }
#endif
}
```
